# Optimizing an MI355X kernel written in HIP

```python
import math
import jax, jax.numpy as jnp
from jax import lax
import numpy as np

D_MODEL = 2048
BATCH = 4
SEQ = 2048
DEPTH = 1

P_DIM = 256
CONV_CH = 1024
CONV_WIDTH = 31
ATTN_HEADS = 8
ATTN_HEAD_DIM = 64
ATTN_V_DIM = 2 * ATTN_HEAD_DIM
Q_BLOCK = 128
N_BRANCHES = 2
PEER_HEADS = 8
PEER_N_KEYS = 128
PEER_N_EXPERTS = PEER_N_KEYS * PEER_N_KEYS
PEER_KEY_DIM = 256
PEER_HALF = PEER_KEY_DIM // 2
PEER_TOPK = 16
TOKEN_BLOCK = 128
LN_EPS = 1e-5
ALPHA = (2.0 * DEPTH) ** 0.25
BETA = (8.0 * DEPTH) ** -0.25

COL_CONV = 2 * CONV_CH
COL_Q = ATTN_HEADS * 2 * ATTN_HEAD_DIM
COL_K = ATTN_HEADS * 2 * ATTN_HEAD_DIM
COL_V = ATTN_HEADS * ATTN_V_DIM
COL_GATE = N_BRANCHES * D_MODEL
IN_COLS = COL_CONV + COL_Q + COL_K + COL_V + COL_GATE
SPLITS = (COL_CONV, COL_CONV + COL_Q, COL_CONV + COL_Q + COL_K, COL_CONV + COL_Q + COL_K + COL_V)

kernel_name = "hybrid_conv_diffattn_peer_deepnorm"


def lambda_init(layer_idx):
    return 0.8 - 0.6 * math.exp(-0.3 * layer_idx)


def layer_norm(x, g, b):
    xf = x.astype(jnp.float32)
    mu = jnp.mean(xf, axis=-1, keepdims=True)
    var = jnp.mean(jnp.square(xf - mu), axis=-1, keepdims=True)
    return ((xf - mu) * lax.rsqrt(var + LN_EPS)).astype(x.dtype) * g + b


def rms_norm(x, g):
    xf = x.astype(jnp.float32)
    ms = jnp.mean(jnp.square(xf), axis=-1, keepdims=True)
    return (xf * lax.rsqrt(ms + LN_EPS)).astype(x.dtype) * g


def alibi_slopes():
    return jnp.asarray(2.0 ** (-8.0 * np.arange(1, ATTN_HEADS + 1) / ATTN_HEADS), dtype=jnp.float32)


def conformer_conv(a, dw_w, dw_b, ln_g, ln_b, w_pw):
    h = a[..., :CONV_CH] * jax.nn.sigmoid(a[..., CONV_CH:])
    h = lax.conv_general_dilated(
        h, dw_w.astype(h.dtype), window_strides=(1,), padding=[(CONV_WIDTH - 1, 0)],
        dimension_numbers=('NWC', 'WIO', 'NWC'), feature_group_count=CONV_CH) + dw_b
    h = layer_norm(h, ln_g, ln_b)
    h = jax.nn.silu(h)
    return h @ w_pw


def diff_attention(q, k, v, lam, lam_init, subln_g, w_o, slopes):
    B, S, _ = q.shape
    nb = S // Q_BLOCK
    scale = ATTN_HEAD_DIM ** -0.5
    qb = q.reshape(B, nb, Q_BLOCK, ATTN_HEADS, 2, ATTN_HEAD_DIM).transpose(1, 0, 3, 4, 2, 5)
    kh = k.reshape(B, S, ATTN_HEADS, 2, ATTN_HEAD_DIM).transpose(0, 2, 3, 1, 4)
    vh = v.reshape(B, S, ATTN_HEADS, ATTN_V_DIM).transpose(0, 2, 1, 3)
    kpos = jnp.arange(S)

    def block(args):
        qblk, bi = args
        s = jnp.einsum('bhmqd,bhmkd->bhmqk', qblk, kh).astype(jnp.float32) * scale
        qpos = bi * Q_BLOCK + jnp.arange(Q_BLOCK)
        dist = qpos[:, None] - kpos[None, :]
        bias = -slopes[:, None, None] * dist.astype(jnp.float32)[None]
        s = jnp.where((dist >= 0)[None, None, None], s + bias[None, :, None], -jnp.inf)
        pr = jax.nn.softmax(s, axis=-1)
        a = pr[:, :, 0] - lam * pr[:, :, 1]
        return jnp.einsum('bhqk,bhkv->bhqv', a.astype(vh.dtype), vh)

    o = lax.map(block, (qb, jnp.arange(nb)))
    o = o.transpose(1, 0, 3, 2, 4).reshape(B, S, ATTN_HEADS, ATTN_V_DIM)
    o = rms_norm(o, subln_g) * (1.0 - lam_init)
    return o.reshape(B, S, ATTN_HEADS * ATTN_V_DIM) @ w_o


def peer(x, w_q, sub_keys, u_tab, v_tab):
    B, S, D = x.shape
    xt = x.reshape((B * S) // TOKEN_BLOCK, TOKEN_BLOCK, D)

    def block(xb):
        q = (xb @ w_q).reshape(TOKEN_BLOCK, PEER_HEADS, 2, PEER_HALF)
        s = jnp.einsum('thcd,hcnd->thcn', q, sub_keys).astype(jnp.float32)
        vals, idx = lax.top_k(s, PEER_TOPK)
        cand = vals[:, :, 0, :, None] + vals[:, :, 1, None, :]
        cand_ids = idx[:, :, 0, :, None] * PEER_N_KEYS + idx[:, :, 1, None, :]
        best, pos = lax.top_k(cand.reshape(TOKEN_BLOCK, PEER_HEADS, PEER_TOPK * PEER_TOPK), PEER_TOPK)
        ids = jnp.take_along_axis(cand_ids.reshape(TOKEN_BLOCK, PEER_HEADS, PEER_TOPK * PEER_TOPK), pos, axis=-1)
        g = jax.nn.softmax(best, axis=-1)
        u = u_tab[ids]
        v = v_tab[ids]
        h = jax.nn.gelu(jnp.einsum('td,thkd->thk', xb, u))
        w = (g * h.astype(jnp.float32)).astype(xb.dtype)
        return jnp.einsum('thk,thkd->td', w, v)

    return lax.map(block, xt).reshape(B, S, D)


def setup_inputs(seed: int = 0) -> dict:
    key = jax.random.key(seed)
    ks = jax.random.split(key, 32)
    f32 = jnp.float32
    L, D = DEPTH, D_MODEL

    def nrm(k, shape, scale):
        return jax.random.normal(k, shape, f32) * scale

    w_in = jnp.concatenate([
        nrm(ks[2], (L, D, COL_CONV), D ** -0.5),
        nrm(ks[3], (L, D, COL_Q + COL_K), D ** -0.5),
        nrm(ks[4], (L, D, COL_V), BETA * D ** -0.5),
        nrm(ks[5], (L, D, COL_GATE), D ** -0.5),
    ], axis=-1)
    return {
        "x": nrm(ks[0], (BATCH, SEQ, D), 1.0),
        "p": nrm(ks[1], (DEPTH, BATCH, SEQ, P_DIM), 1.0),
        "w_in": w_in,
        "b_gate": nrm(ks[6], (L, COL_GATE), 0.02),
        "conv_dw_w": nrm(ks[7], (L, CONV_WIDTH, 1, CONV_CH), CONV_WIDTH ** -0.5),
        "conv_dw_b": nrm(ks[8], (L, CONV_CH), 0.02),
        "conv_ln_g": 1.0 + nrm(ks[9], (L, CONV_CH), 0.02),
        "conv_ln_b": nrm(ks[10], (L, CONV_CH), 0.02),
        "conv_w_out": nrm(ks[11], (L, CONV_CH, D), BETA * CONV_CH ** -0.5),
        "attn_lambda_q1": nrm(ks[12], (L, ATTN_HEAD_DIM), 0.1),
        "attn_lambda_k1": nrm(ks[13], (L, ATTN_HEAD_DIM), 0.1),
        "attn_lambda_q2": nrm(ks[14], (L, ATTN_HEAD_DIM), 0.1),
        "attn_lambda_k2": nrm(ks[15], (L, ATTN_HEAD_DIM), 0.1),
        "attn_subln_g": 1.0 + nrm(ks[16], (L, ATTN_V_DIM), 0.02),
        "attn_w_o": nrm(ks[17], (L, COL_V, D), BETA * COL_V ** -0.5),
        "w_out": nrm(ks[18], (L, D, D), BETA * D ** -0.5),
        "ln1_g": 1.0 + nrm(ks[19], (L, D), 0.02),
        "ln1_b": nrm(ks[20], (L, D), 0.02),
        "peer_w_q": nrm(ks[21], (L, D, PEER_HEADS * PEER_KEY_DIM), D ** -0.5),
        "peer_sub_keys": nrm(ks[22], (L, PEER_HEADS, 2, PEER_N_KEYS, PEER_HALF), PEER_HALF ** -0.5),
        "peer_u": nrm(ks[23], (L, PEER_N_EXPERTS, D), D ** -0.5),
        "peer_v": nrm(ks[24], (L, PEER_N_EXPERTS, D), BETA),
        "ln2_g": 1.0 + nrm(ks[25], (L, D), 0.02),
        "ln2_b": nrm(ks[26], (L, D), 0.02),
        "ple_w_proj": nrm(ks[27], (L, P_DIM, D), BETA * P_DIM ** -0.5),
        "ple_w_gate": nrm(ks[28], (L, D, D), D ** -0.5),
        "ple_b_gate": nrm(ks[29], (L, D), 0.02),
    }


def reference(x, p, w_in, b_gate, conv_dw_w, conv_dw_b, conv_ln_g, conv_ln_b, conv_w_out,
              attn_lambda_q1, attn_lambda_k1, attn_lambda_q2, attn_lambda_k2, attn_subln_g, attn_w_o,
              w_out, ln1_g, ln1_b, peer_w_q, peer_sub_keys, peer_u, peer_v, ln2_g, ln2_b,
              ple_w_proj, ple_w_gate, ple_b_gate):
    B, S, D = x.shape
    slopes = alibi_slopes()
    for i in range(DEPTH):
        lam_init = lambda_init(i)
        proj = x @ w_in[i]
        a_conv, q, k, v, g_logits = jnp.split(proj, SPLITS, axis=-1)
        y_conv = conformer_conv(a_conv, conv_dw_w[i], conv_dw_b[i], conv_ln_g[i], conv_ln_b[i], conv_w_out[i])
        lam = (jnp.exp(jnp.sum(attn_lambda_q1[i] * attn_lambda_k1[i]).astype(jnp.float32))
               - jnp.exp(jnp.sum(attn_lambda_q2[i] * attn_lambda_k2[i]).astype(jnp.float32)) + lam_init)
        y_attn = diff_attention(q, k, v, lam, lam_init, attn_subln_g[i], attn_w_o[i], slopes)
        gates = jax.nn.sigmoid(g_logits + b_gate[i]).reshape(B, S, N_BRANCHES, D)
        mixed = gates[:, :, 0] * y_conv + gates[:, :, 1] * y_attn
        x = layer_norm(ALPHA * x + mixed @ w_out[i], ln1_g[i], ln1_b[i])
        x = layer_norm(ALPHA * x + peer(x, peer_w_q[i], peer_sub_keys[i], peer_u[i], peer_v[i]), ln2_g[i], ln2_b[i])
        e = p[i] @ ple_w_proj[i]
        x = x + jax.nn.sigmoid(x @ ple_w_gate[i] + ple_b_gate[i]) * e
    return x
```

```cpp
#include <hip/hip_runtime.h>
#include <cstdio>
#include <cstdint>
#include <cmath>

constexpr int DM = 2048, BATCH = 4, SEQ = 2048, MTOK = BATCH * SEQ;
constexpr int P_DIM = 256, CONV_CH = 1024, CONV_W = 31, AH = 8, AHD = 64, AVD = 128;
constexpr int PH = 8, PNK = 128, PHALF = 128, PTOPK = 16, NEXP = PNK * PNK;
constexpr int COL_CONV = 2048, COL_Q = 1024, COL_K = 1024, COL_V = 1024, COL_GATE = 4096, IN_COLS = 9216;
constexpr int OFF_Q = 2048, OFF_K = 3072, OFF_V = 4096, OFF_G = 5120;
constexpr float LN_EPS = 1e-5f;
constexpr float ALPHA = 1.189207115002721f;
constexpr float LAM_INIT = 0.2f;
constexpr float LOG2E = 1.4426950408889634f;
constexpr float QSCALE = 0.125f * LOG2E;

typedef unsigned short bf16_t;
__device__ __forceinline__ unsigned f2bf(float f) { unsigned u = __builtin_bit_cast(unsigned, f); return (u + 0x7fffu + ((u >> 16) & 1u)) >> 16; }
__device__ __forceinline__ float bf2f(unsigned h) { return __builtin_bit_cast(float, h << 16); }
__device__ __forceinline__ float sigmoidf_(float v) { return 1.0f / (1.0f + __expf(-v)); }
__device__ __forceinline__ float gelu_tanh(float v) { const float u = 0.7978845608028654f * (v + 0.044715f * v * v * v); return 0.5f * v * (1.0f + tanhf(u)); }

constexpr size_t MiB = 1u << 20;
constexpr size_t WS_CTL = 0;
constexpr size_t WS_SK = 1 * MiB;
constexpr size_t WS_PB = 2 * MiB;
constexpr size_t WS_WCT = 6 * MiB, WS_WOT = 10 * MiB, WS_WOUTT = 14 * MiB, WS_WQT = 22 * MiB, WS_WPGT = 30 * MiB, WS_WPT = 38 * MiB;
constexpr size_t WS_UB = 40 * MiB, WS_VB = 104 * MiB;
constexpr size_t WS_XB = 168 * MiB;
constexpr size_t WS_MIXED = WS_XB, WS_X1B = WS_XB;
constexpr size_t WS_WINT = 200 * MiB;
constexpr size_t WS_HC = 200 * MiB, WS_ON = 216 * MiB, WS_QP = 200 * MiB, WS_X2B = 200 * MiB;
constexpr size_t WS_HGLU = 236 * MiB, WS_QB = 252 * MiB, WS_KB = 268 * MiB, WS_VT = 284 * MiB;
constexpr size_t WS_T1 = 236 * MiB;
constexpr size_t WS_X2F = 236 * MiB;
constexpr size_t WS_GT = 300 * MiB;
constexpr size_t WS_X1F = 300 * MiB;
constexpr size_t WS_E = 364 * MiB;
constexpr size_t WS_IDS = 364 * MiB, WS_GW = 368 * MiB;
constexpr size_t WS_NT = 428 * MiB;
constexpr size_t WS_NTK = 492 * MiB;
constexpr size_t WS_END = 508 * MiB;

template <typename TA> __device__ __forceinline__ float ldA(const TA* p);
template <> __device__ __forceinline__ float ldA<float>(const float* p) { return *p; }
template <> __device__ __forceinline__ float ldA<bf16_t>(const bf16_t* p) { return bf2f(*p); }
template <typename TA>
__global__ void __launch_bounds__(256) ngemm(const TA* __restrict__ A, int lda, const float* __restrict__ B, int ldb, float* __restrict__ C, int ldc, int K) {
    __shared__ float As[16][65];
    __shared__ float Bs[16][65];
    const int tid = threadIdx.x, tx = tid & 15, ty = tid >> 4;
    const int m0 = blockIdx.y * 64, n0 = blockIdx.x * 64;
    float acc[4][4];
#pragma unroll
    for (int i = 0; i < 4; ++i)
#pragma unroll
        for (int j = 0; j < 4; ++j) acc[i][j] = 0.f;
    for (int k0 = 0; k0 < K; k0 += 16) {
#pragma unroll
        for (int i = 0; i < 4; ++i) { const int idx = tid + i * 256; const int r = idx >> 4, c = idx & 15; As[c][r] = ldA<TA>(A + (size_t)(m0 + r) * lda + k0 + c); }
#pragma unroll
        for (int i = 0; i < 4; ++i) { const int idx = tid + i * 256; const int r = idx >> 6, c = idx & 63; Bs[r][c] = B[(size_t)(k0 + r) * ldb + n0 + c]; }
        __syncthreads();
#pragma unroll
        for (int kk = 0; kk < 16; ++kk) {
            float a[4], b[4];
#pragma unroll
            for (int i = 0; i < 4; ++i) { a[i] = As[kk][ty * 4 + i]; b[i] = Bs[kk][tx * 4 + i]; }
#pragma unroll
            for (int i = 0; i < 4; ++i)
#pragma unroll
                for (int j = 0; j < 4; ++j) acc[i][j] = fmaf(a[i], b[j], acc[i][j]);
        }
        __syncthreads();
    }
#pragma unroll
    for (int i = 0; i < 4; ++i)
#pragma unroll
        for (int j = 0; j < 4; ++j) C[(size_t)(m0 + ty * 4 + i) * ldc + n0 + tx * 4 + j] = acc[i][j];
}

__global__ void n_cvt_bf16(const float* __restrict__ src, bf16_t* __restrict__ dst, size_t n) {
    for (size_t i = (size_t)blockIdx.x * blockDim.x + threadIdx.x; i < n; i += (size_t)gridDim.x * blockDim.x) dst[i] = (bf16_t)f2bf(src[i]);
}
__global__ void n_glu(const float* __restrict__ T, bf16_t* __restrict__ hglu) {
    for (size_t i = (size_t)blockIdx.x * blockDim.x + threadIdx.x; i < (size_t)MTOK * CONV_CH; i += (size_t)gridDim.x * blockDim.x) {
        const size_t m = i / CONV_CH, c = i % CONV_CH; hglu[i] = (bf16_t)f2bf(T[m * 2048 + c] * sigmoidf_(T[m * 2048 + 1024 + c])); }
}
__global__ void n_scale_bf16(const float* __restrict__ T, bf16_t* __restrict__ dst, float s, size_t n) {
    for (size_t i = (size_t)blockIdx.x * blockDim.x + threadIdx.x; i < n; i += (size_t)gridDim.x * blockDim.x) dst[i] = (bf16_t)f2bf(T[i] * s);
}
__global__ void n_vt(const float* __restrict__ T, bf16_t* __restrict__ VT) {
    for (size_t i = (size_t)blockIdx.x * blockDim.x + threadIdx.x; i < (size_t)MTOK * 1024; i += (size_t)gridDim.x * blockDim.x) {
        const size_t c = i / MTOK, m = i % MTOK; VT[i] = (bf16_t)f2bf(T[m * 1024 + c]); }
}
__global__ void n_gate(const float* __restrict__ T, const float* __restrict__ bg, bf16_t* __restrict__ Gt, int coff) {
    for (size_t i = (size_t)blockIdx.x * blockDim.x + threadIdx.x; i < (size_t)MTOK * 2048; i += (size_t)gridDim.x * blockDim.x) {
        const size_t m = i / 2048, c = i % 2048; Gt[m * 4096 + coff + c] = (bf16_t)f2bf(sigmoidf_(T[i] + bg[coff + c])); }
}
__global__ void n_dwconv(const bf16_t* __restrict__ hglu, const float* __restrict__ w, const float* __restrict__ b, float* __restrict__ T) {
    for (size_t i = (size_t)blockIdx.x * blockDim.x + threadIdx.x; i < (size_t)MTOK * CONV_CH; i += (size_t)gridDim.x * blockDim.x) {
        const int m = (int)(i / CONV_CH), c = (int)(i % CONV_CH), s = m % SEQ; float acc = b[c];
        for (int j = 0; j < CONV_W; ++j) { const int sp = s - (CONV_W - 1) + j; if (sp >= 0) acc = fmaf(bf2f(hglu[(size_t)(m - (CONV_W - 1) + j) * CONV_CH + c]), w[j * CONV_CH + c], acc); }
        T[i] = acc; }
}
__device__ __forceinline__ float block_sum_256(float v, float* red) {
#pragma unroll
    for (int o = 32; o > 0; o >>= 1) v += __shfl_xor(v, o);
    __syncthreads();
    if ((threadIdx.x & 63) == 0) red[threadIdx.x >> 6] = v;
    __syncthreads();
    return red[0] + red[1] + red[2] + red[3];
}
__global__ void __launch_bounds__(256) n_convln(const float* __restrict__ T, const float* __restrict__ g, const float* __restrict__ b, bf16_t* __restrict__ hc) {
    __shared__ float red[4];
    const int m = blockIdx.x, t = threadIdx.x; float v[4]; float s = 0.f;
#pragma unroll
    for (int i = 0; i < 4; ++i) { v[i] = T[(size_t)m * CONV_CH + t + 256 * i]; s += v[i]; }
    const float mean = block_sum_256(s, red) * (1.f / CONV_CH); float q = 0.f;
#pragma unroll
    for (int i = 0; i < 4; ++i) { v[i] -= mean; q += v[i] * v[i]; }
    const float rstd = rsqrtf(block_sum_256(q, red) * (1.f / CONV_CH) + LN_EPS);
#pragma unroll
    for (int i = 0; i < 4; ++i) { const int c = t + 256 * i; const float y = v[i] * rstd * g[c] + b[c]; hc[(size_t)m * CONV_CH + c] = (bf16_t)f2bf(y * sigmoidf_(y)); }
}
__global__ void n_subln(const float* __restrict__ T, const float* __restrict__ g, bf16_t* __restrict__ on) {
    const int i = blockIdx.x * blockDim.x + threadIdx.x; if (i >= MTOK * AH) return;
    const float* r = T + (size_t)i * 128; float ss = 0.f;
    for (int d = 0; d < 128; ++d) ss += r[d] * r[d];
    const float rs = rsqrtf(ss * (1.f / 128.f) + LN_EPS) * (1.f - LAM_INIT);
    for (int d = 0; d < 128; ++d) on[(size_t)i * 128 + d] = (bf16_t)f2bf(r[d] * rs * g[d]);
}
__global__ void n_mix(const float* __restrict__ T1, const float* __restrict__ T2, const bf16_t* __restrict__ Gt, bf16_t* __restrict__ mixed) {
    for (size_t i = (size_t)blockIdx.x * blockDim.x + threadIdx.x; i < (size_t)MTOK * DM; i += (size_t)gridDim.x * blockDim.x) {
        const size_t m = i / DM, c = i % DM; mixed[i] = (bf16_t)f2bf(bf2f(Gt[m * 4096 + c]) * T1[i] + bf2f(Gt[m * 4096 + 2048 + c]) * T2[i]); }
}
__global__ void __launch_bounds__(256) n_resln(const float* __restrict__ res, const float* __restrict__ add, const float* __restrict__ g, const float* __restrict__ b, float* __restrict__ yf, bf16_t* __restrict__ yb) {
    __shared__ float red[4];
    const int m = blockIdx.x, t = threadIdx.x; float v[8]; float s = 0.f;
#pragma unroll
    for (int i = 0; i < 8; ++i) { const size_t o = (size_t)m * DM + t + 256 * i; v[i] = ALPHA * res[o] + add[o]; s += v[i]; }
    const float mean = block_sum_256(s, red) * (1.f / DM); float q = 0.f;
#pragma unroll
    for (int i = 0; i < 8; ++i) { v[i] -= mean; q += v[i] * v[i]; }
    const float rstd = rsqrtf(block_sum_256(q, red) * (1.f / DM) + LN_EPS);
#pragma unroll
    for (int i = 0; i < 8; ++i) { const int c = t + 256 * i; const float y = v[i] * rstd * g[c] + b[c]; yf[(size_t)m * DM + c] = y; yb[(size_t)m * DM + c] = (bf16_t)f2bf(y); }
}
__global__ void n_scores(const bf16_t* __restrict__ qp, const float* __restrict__ sk, float* __restrict__ S) {
    for (size_t i = (size_t)blockIdx.x * blockDim.x + threadIdx.x; i < (size_t)MTOK * 2048; i += (size_t)gridDim.x * blockDim.x) {
        const size_t m = i / 2048; const int r = (int)(i % 2048), hc = r / 128, n = r % 128; float s = 0.f;
        for (int d = 0; d < 128; ++d) s = fmaf(bf2f(qp[m * 2048 + hc * 128 + d]), bf2f((unsigned)f2bf(sk[((size_t)hc * 128 + n) * 128 + d])), s);
        S[i] = s; }
}
__global__ void n_topk1(const float* __restrict__ S, float* __restrict__ vals, int* __restrict__ idx) {
    const int i = blockIdx.x * blockDim.x + threadIdx.x; if (i >= MTOK * 16) return;
    const float* s = S + (size_t)i * 128; float pv = INFINITY; int pi = -1;
    for (int r = 0; r < 16; ++r) { float bv = -INFINITY; int bi = 0x7fffffff;
        for (int n = 0; n < 128; ++n) { const float v = s[n]; const bool elig = (v < pv) || (v == pv && n > pi); if (elig && (v > bv || (v == bv && n < bi))) { bv = v; bi = n; } }
        vals[(size_t)i * 16 + r] = bv; idx[(size_t)i * 16 + r] = bi; pv = bv; pi = bi; }
}
__global__ void n_topk2(const float* __restrict__ vals, const int* __restrict__ idx, int* __restrict__ ids, float* __restrict__ gw) {
    const int i = blockIdx.x * blockDim.x + threadIdx.x; if (i >= MTOK * 8) return;
    const float* v0 = vals + (size_t)i * 32; const float* v1 = v0 + 16; const int* i0 = idx + (size_t)i * 32; const int* i1 = i0 + 16;
    float best[16]; float pv = INFINITY; int pf = -1;
#pragma unroll
    for (int r = 0; r < 16; ++r) { float bv = -INFINITY; int bf = 0x7fffffff;
        for (int f = 0; f < 256; ++f) { const float v = v0[f >> 4] + v1[f & 15]; const bool elig = (v < pv) || (v == pv && f > pf); if (elig && (v > bv || (v == bv && f < bf))) { bv = v; bf = f; } }
        best[r] = bv; ids[(size_t)i * 16 + r] = i0[bf >> 4] * PNK + i1[bf & 15]; pv = bv; pf = bf; }
    float sum = 0.f; const float bmax = best[0];
#pragma unroll
    for (int r = 0; r < 16; ++r) { best[r] = __expf(best[r] - bmax); sum += best[r]; }
    const float inv = 1.f / sum;
#pragma unroll
    for (int r = 0; r < 16; ++r) gw[(size_t)i * 16 + r] = best[r] * inv;
}
__global__ void __launch_bounds__(256) n_peer(const bf16_t* __restrict__ x1b, const float* __restrict__ x1f, const int* __restrict__ ids, const float* __restrict__ gw,
                                              const float* __restrict__ ut, const float* __restrict__ vt, const float* __restrict__ g, const float* __restrict__ b,
                                              float* __restrict__ x2f, bf16_t* __restrict__ x2b) {
    __shared__ float red[4]; __shared__ float wj[128];
    const int m = blockIdx.x, t = threadIdx.x; float xr[8];
#pragma unroll
    for (int i = 0; i < 8; ++i) xr[i] = bf2f(x1b[(size_t)m * DM + t + 256 * i]);
    for (int j = 0; j < 128; ++j) { const float* u = ut + (size_t)ids[(size_t)m * 128 + j] * DM; float s = 0.f;
#pragma unroll
        for (int i = 0; i < 8; ++i) s = fmaf(xr[i], u[t + 256 * i], s);
        const float hsum = block_sum_256(s, red);
        if (t == 0) wj[j] = gw[(size_t)m * 128 + j] * gelu_tanh(hsum); }
    __syncthreads();
    float o[8];
#pragma unroll
    for (int i = 0; i < 8; ++i) o[i] = 0.f;
    for (int j = 0; j < 128; ++j) { const float* v = vt + (size_t)ids[(size_t)m * 128 + j] * DM; const float w = wj[j];
#pragma unroll
        for (int i = 0; i < 8; ++i) o[i] = fmaf(w, v[t + 256 * i], o[i]); }
    float s = 0.f;
#pragma unroll
    for (int i = 0; i < 8; ++i) { o[i] += ALPHA * x1f[(size_t)m * DM + t + 256 * i]; s += o[i]; }
    const float mean = block_sum_256(s, red) * (1.f / DM); float q = 0.f;
#pragma unroll
    for (int i = 0; i < 8; ++i) { o[i] -= mean; q += o[i] * o[i]; }
    const float rstd = rsqrtf(block_sum_256(q, red) * (1.f / DM) + LN_EPS);
#pragma unroll
    for (int i = 0; i < 8; ++i) { const int c = t + 256 * i; const float y = o[i] * rstd * g[c] + b[c]; x2f[(size_t)m * DM + c] = y; x2b[(size_t)m * DM + c] = (bf16_t)f2bf(y); }
}
__global__ void n_final(const float* __restrict__ x2f, const float* __restrict__ T, const float* __restrict__ bg, const float* __restrict__ E, float* __restrict__ out) {
    for (size_t i = (size_t)blockIdx.x * blockDim.x + threadIdx.x; i < (size_t)MTOK * DM; i += (size_t)gridDim.x * blockDim.x) {
        const size_t c = i % DM; out[i] = x2f[i] + sigmoidf_(T[i] + bg[c]) * E[i]; }
}
__global__ void n_lambda(const float* q1, const float* k1, const float* q2, const float* k2, float* lam) {
    if (threadIdx.x == 0 && blockIdx.x == 0) { float a = 0.f, b = 0.f; for (int i = 0; i < 64; ++i) { a += q1[i] * k1[i]; b += q2[i] * k2[i]; } lam[0] = expf(a) - expf(b) + LAM_INIT; }
}

enum { I_X = 0, I_P, I_WIN, I_BGATE, I_DWW, I_DWB, I_CLNG, I_CLNB, I_CWOUT, I_LQ1, I_LK1, I_LQ2, I_LK2, I_SUBLN, I_AWO, I_WOUT, I_LN1G, I_LN1B, I_PWQ, I_PSK, I_PU, I_PV, I_LN2G, I_LN2B, I_PLEWP, I_PLEWG, I_PLEBG, N_IN };
__global__ void __launch_bounds__(64) n_attn2(const bf16_t* __restrict__ Qb, const bf16_t* __restrict__ Kb, const bf16_t* __restrict__ VT, const float* __restrict__ lamp, float* __restrict__ T) {
    const float lam = lamp[0];
    const int q = blockIdx.x * 64 + threadIdx.x, chunk = blockIdx.y, bh = blockIdx.z, b = bh / AH, h = bh % AH;
    const float slope2 = exp2f(-(float)(h + 1)) * LOG2E;
    const size_t rowq = (size_t)b * SEQ + q;
    float res[32];
#pragma unroll
    for (int d = 0; d < 32; ++d) res[d] = 0.f;
    const int kmax = blockIdx.x * 64 + 63;
    for (int map = 0; map < 2; ++map) {
        float qv[64];
#pragma unroll
        for (int d = 0; d < 64; ++d) qv[d] = bf2f(Qb[rowq * 1024 + h * 128 + map * 64 + d]);
        float o[32];
#pragma unroll
        for (int d = 0; d < 32; ++d) o[d] = 0.f;
        float mx = -INFINITY, l = 0.f;
        for (int k = 0; k <= kmax; ++k) {
            const bf16_t* kr = Kb + ((size_t)b * SEQ + k) * 1024 + h * 128 + map * 64; float s = 0.f;
#pragma unroll
            for (int d = 0; d < 64; ++d) s = fmaf(qv[d], bf2f(kr[d]), s);
            s -= slope2 * (float)(q - k);
            if (k <= q) {
                const float mn = fmaxf(mx, s), c = exp2f(mx - mn), p = exp2f(s - mn); l = l * c + p; mx = mn;
#pragma unroll
                for (int d = 0; d < 32; ++d) o[d] = o[d] * c + p * bf2f(VT[(size_t)(h * 128 + chunk * 32 + d) * MTOK + (size_t)b * SEQ + k]);
            }
        }
        const float il = 1.f / l, sg = map == 0 ? 1.f : -lam;
#pragma unroll
        for (int d = 0; d < 32; ++d) res[d] += sg * o[d] * il;
    }
#pragma unroll
    for (int d = 0; d < 32; ++d) T[rowq * 1024 + h * 128 + chunk * 32 + d] = res[d];
}

#define GAS __attribute__((address_space(1)))
#define LAS __attribute__((address_space(3)))
typedef short bf16x8 __attribute__((ext_vector_type(8)));
typedef float f32x4 __attribute__((ext_vector_type(4)));
typedef float f32x2 __attribute__((ext_vector_type(2)));
typedef float f32x16 __attribute__((ext_vector_type(16)));
typedef unsigned u32x4 __attribute__((ext_vector_type(4)));
typedef unsigned u32x2 __attribute__((ext_vector_type(2)));
typedef __bf16 bf16x2_t __attribute__((ext_vector_type(2)));
typedef GAS unsigned gu32;
#define RLX_AGENT __ATOMIC_RELAXED, __HIP_MEMORY_SCOPE_AGENT
#define LDS_WAIT() asm volatile("s_waitcnt lgkmcnt(0)" ::: "memory")
#define VM_WAIT() asm volatile("s_waitcnt vmcnt(0)" ::: "memory")
constexpr int NWAVES = 8, NTHREADS = 512;
constexpr int RING_BYTES = 131072;
constexpr int XTRA_OFF = RING_BYTES;
constexpr int MISC_OFF = 161792;
constexpr int LDS_BYTES = 163840;

__device__ __forceinline__ unsigned pk2(float lo, float hi) { f32x2 v = {lo, hi}; bf16x2_t b = __builtin_convertvector(v, bf16x2_t); return __builtin_bit_cast(unsigned, b); }
__device__ __forceinline__ float bflo(unsigned w) { return __builtin_bit_cast(float, w << 16); }
__device__ __forceinline__ float bfhi(unsigned w) { return __builtin_bit_cast(float, w & 0xffff0000u); }
__device__ __forceinline__ float fsigmoid(float v) { return __builtin_amdgcn_rcpf(1.0f + __builtin_amdgcn_exp2f(-LOG2E * v)); }

#define XB_TMO      128
#define XB_XCNT(j)  (256  + 64 * (j))
#define XB_XSUB(j)  (1280 + 64 * (j))
#define XB_XGEN(j)  (2304 + 64 * (j))
#define XB_TOP      3328
#define XB_TOPGEN   3392
#define XCD_BAR_WORDS 3456
#define XB_SPIN_CAP (1u << 22)
__device__ __forceinline__ unsigned xb_ld(unsigned* p)              { return __hip_atomic_load(p, __ATOMIC_RELAXED, __HIP_MEMORY_SCOPE_AGENT); }
__device__ __forceinline__ unsigned xb_add(unsigned* p, unsigned v) { return __hip_atomic_fetch_add(p, v, __ATOMIC_RELAXED, __HIP_MEMORY_SCOPE_AGENT); }
__device__ __forceinline__ unsigned xb_xcc_id() { return (unsigned)__builtin_amdgcn_s_getreg((3 << 11) | 20) & 0xFu; }
#define XB_SPIN(cond, bar) do { unsigned _sp = 0; while (cond) { __builtin_amdgcn_s_sleep(1); \
    if ((++_sp & 255u) == 0u) { if (xb_ld(&(bar)[XB_TMO])) break; if (_sp > XB_SPIN_CAP) { atomicAdd(&(bar)[XB_TMO], 1u); break; } } } } while (0)
struct XcdBarrier { unsigned* bar; unsigned x; volatile LAS unsigned* st; };
__device__ __forceinline__ XcdBarrier xcd_barrier_post(unsigned* bar, volatile LAS unsigned* st) {
    XcdBarrier b; b.bar = bar; b.x = xb_xcc_id(); b.st = st;
    if (threadIdx.x == 0) (void)xb_add(&bar[XB_XCNT(b.x)], 1u);
    return b;
}
__device__ __forceinline__ void xcd_barrier_complete(unsigned* bar, unsigned x, unsigned& nloc, unsigned& nx) {
    const unsigned G = gridDim.x * gridDim.y * gridDim.z;
    unsigned sum, cnt, mine, sp = 0u;
    for (;;) {
        sum = 0u; cnt = 0u; mine = 0u;
#pragma unroll
        for (unsigned j = 0; j < 16; ++j) { const unsigned c = xb_ld(&bar[XB_XCNT(j)]); sum += c; cnt += (c > 0u) ? 1u : 0u; mine = (j == x) ? c : mine; }
        if (sum == G) break;
        __builtin_amdgcn_s_sleep(1);
        if ((++sp & 255u) == 0u) { if (xb_ld(&bar[XB_TMO])) break; if (sp > XB_SPIN_CAP) { atomicAdd(&bar[XB_TMO], 1u); break; } }
    }
    nloc = mine > 0u ? mine : 1u; nx = cnt > 0u ? cnt : 1u;
}
__device__ __forceinline__ void xcd_barrier(const XcdBarrier& b) {
    asm volatile("s_waitcnt vmcnt(0)" ::: "memory");
    __syncthreads();
    if (threadIdx.x == 0) {
        unsigned* bar = b.bar;
        __builtin_amdgcn_s_waitcnt(0);
        unsigned nloc = b.st[0], nx = b.st[1];
        if (nloc == 0u) { xcd_barrier_complete(bar, b.x, nloc, nx); b.st[0] = nloc; b.st[1] = nx; }
        const unsigned old = xb_add(&bar[XB_XSUB(b.x)], 1u);
        const unsigned gen = old / nloc;
        if (old + 1u == (gen + 1u) * nloc) {
            __builtin_amdgcn_fence(__ATOMIC_RELEASE, "agent");
            asm volatile("s_waitcnt vmcnt(0)" ::: "memory");
            const unsigned og = xb_add(&bar[XB_TOP], 1u);
            const unsigned tg = og / nx;
            if (og + 1u == (tg + 1u) * nx) xb_add(&bar[XB_TOPGEN], 1u);
            else XB_SPIN(xb_ld(&bar[XB_TOPGEN]) == tg, bar);
            __builtin_amdgcn_fence(__ATOMIC_ACQUIRE, "agent");
            xb_add(&bar[XB_XGEN(b.x)], 1u);
            asm volatile("s_waitcnt vmcnt(0)" ::: "memory");
        } else {
            XB_SPIN(xb_ld(&bar[XB_XGEN(b.x)]) == gen, bar);
            __builtin_amdgcn_fence(__ATOMIC_ACQUIRE, "agent");
            asm volatile("s_waitcnt vmcnt(0)" ::: "memory");
        }
    }
    __syncthreads();
}

namespace pg8 {
constexpr int BM = 256, BK = 64, HALF = 128, HTB = HALF * BK * 2, STAGE_BYTES = 8 * HTB, NXCD = 8, WGM = 8;
__host__ __device__ __forceinline__ int lds_byte(int r, int c) { const int st = (r >> 4) * 2 + (c >> 5), rr = r & 15, cc = c & 31, ob = rr * 64 + cc * 2; return st * 1024 + (ob ^ (((ob >> 9) & 1) << 5)); }
__host__ __device__ __forceinline__ void stage_rc(int b, int& R, int& C) { const int st = b / 1024, sb = b % 1024, swz = sb ^ (((sb >> 9) & 1) << 5); R = (st >> 1) * 16 + swz / 64; C = (st & 1) * 32 + (swz % 64) / 2; }
__host__ __device__ __forceinline__ int perm32(int rho) { const int n = rho >> 4, i = rho & 15; return 8 * (i >> 2) + 4 * n + (i & 3); }
struct Unit { int pm, pn; };
struct Gemm { const bf16_t* A; const bf16_t* Bt; int lda, ldb, K; };
struct StaticOrder {
    int nM, nN, nwg, G, c;
    __host__ __device__ void init(int M, int N, int G_, int c_) { nM = M / BM; nN = N / BM; nwg = nM * nN; G = G_; c = c_; }
    __host__ __device__ bool next(int i, Unit& u) const {
        const long L = (long)i * G + c; if (L >= nwg) return false;
        int wgid = (int)L; { const int q = nwg / NXCD, r = nwg % NXCD, xcd = wgid % NXCD, off = wgid / NXCD; wgid = (xcd < r ? xcd * (q + 1) : r * (q + 1) + (xcd - r) * q) + off; }
        const int nig = WGM * nN, gid = wgid / nig, fm = gid * WGM, gsz = (nM - fm) < WGM ? (nM - fm) : WGM;
        u.pm = fm + ((wgid % nig) % gsz); u.pn = (wgid % nig) / gsz; return true;
    }
};
template <class Epi, bool SP2 = true>
__device__ __forceinline__ void gemm_phase(LAS unsigned char* lds, const Gemm g, const StaticOrder& S, const Epi& E) {
    int tid_ = threadIdx.x; asm volatile("" : "+v"(tid_));
    const int tid = tid_, wid = __builtin_amdgcn_readfirstlane(tid >> 6), lane = tid & 63, wr = wid >> 2, wc = wid & 3, fr = lane & 15, fq = lane >> 4;
    const int K = g.K, nt = K / BK;
    unsigned voffA[2], voffB[2];
#pragma unroll
    for (int i = 0; i < 2; ++i) { int R, C; stage_rc(tid * 16 + i * 8192, R, C); const int Rb = Epi::PERM ? ((R & ~31) + perm32(R & 31)) : R;
        voffA[i] = (unsigned)(R * g.lda + C) * 2u; voffB[i] = (unsigned)(Rb * g.ldb + C) * 2u; }
    const size_t kstep = (size_t)(BK * 2);
    const size_t hstepA = (size_t)HALF * g.lda * 2, hstepB = (size_t)HALF * g.ldb * 2;
    const size_t tstepA = 2 * hstepA, tstepB = 2 * hstepB;
    const unsigned ldsw = (unsigned)wid * 1024u;
    const int aoff = lds_byte(wr * 64 + fr, fq * 8), boff = lds_byte(wc * 32 + fr, fq * 8);
#define PG8_SA(b, h) (((b) * 2 + (h)) * HTB)
#define PG8_SB(b, h) ((4 + (b) * 2 + (h)) * HTB)
#define PG8_STAGE(bufoff, gbase, voff) do { _Pragma("unroll") for (int _i = 0; _i < 2; ++_i) \
        __builtin_amdgcn_global_load_lds((const unsigned*)((const char*)(gbase) + (voff)[_i]), (LAS unsigned*)(lds + (bufoff) + ldsw + _i * 8192), 16, 0, 0); } while (0)
#define PG8_LDA(dst, b, h) do { _Pragma("unroll") for (int m = 0; m < 4; ++m) _Pragma("unroll") for (int k = 0; k < 2; ++k) dst[m][k] = *(const LAS bf16x8*)(lds + PG8_SA(b, h) + aoff + m * 2048 + k * 1024); } while (0)
#define PG8_LDB(dst, b, h) do { _Pragma("unroll") for (int n = 0; n < 2; ++n) _Pragma("unroll") for (int k = 0; k < 2; ++k) dst[n][k] = *(const LAS bf16x8*)(lds + PG8_SB(b, h) + boff + n * 2048 + k * 1024); } while (0)
#define PG8_MMA(ai, bj, At, Bt) do { __builtin_amdgcn_s_setprio(1); _Pragma("unroll") for (int m = 0; m < 4; ++m) _Pragma("unroll") for (int n = 0; n < 2; ++n) _Pragma("unroll") for (int k = 0; k < 2; ++k) \
        acc[ai][bj][m][n] = __builtin_amdgcn_mfma_f32_16x16x32_bf16(Bt[n][k], At[m][k], acc[ai][bj][m][n], 0, 0, 0); __builtin_amdgcn_s_setprio(0); } while (0)
#define PG8_WAIT_V(n) asm volatile("s_waitcnt vmcnt(" #n ")" ::: "memory")
#define PG8_WAIT_L(n) asm volatile("s_waitcnt lgkmcnt(" #n ")" ::: "memory")
#define PG8_BAR __builtin_amdgcn_s_barrier()
#define PG8_SCHED __builtin_amdgcn_sched_barrier(0)
    Unit cur, nxt; int ui = 0;
    if (!S.next(0, cur)) return;
    f32x4 acc[2][2][4][2];
#pragma unroll
    for (int a = 0; a < 2; ++a)
#pragma unroll
        for (int b = 0; b < 2; ++b)
#pragma unroll
            for (int m = 0; m < 4; ++m)
#pragma unroll
                for (int n = 0; n < 2; ++n) acc[a][b][m][n] = (f32x4){0.f, 0.f, 0.f, 0.f};
    bf16x8 At[4][2], B0[2][2], B1[2][2];
    const char* cA = (const char*)g.A + (size_t)cur.pm * tstepA; const char* cB = (const char*)g.Bt + (size_t)cur.pn * tstepB;
    if constexpr (SP2) {
        PG8_STAGE(PG8_SB(0, 0), cB, voffB); PG8_STAGE(PG8_SB(0, 1), cB + hstepB, voffB); PG8_STAGE(PG8_SA(0, 0), cA, voffA); PG8_STAGE(PG8_SA(0, 1), cA + hstepA, voffA);
        if (wr == 1) PG8_BAR;
        PG8_WAIT_V(2); PG8_BAR;
        PG8_STAGE(PG8_SB(1, 0), cB + kstep, voffB); PG8_STAGE(PG8_SA(1, 0), cA + kstep, voffA); PG8_STAGE(PG8_SB(1, 1), cB + hstepB + kstep, voffB);
        PG8_WAIT_V(6); PG8_BAR;
    } else {
        PG8_STAGE(PG8_SB(0, 0), cB, voffB); PG8_STAGE(PG8_SA(0, 0), cA, voffA); PG8_STAGE(PG8_SB(0, 1), cB + hstepB, voffB); PG8_STAGE(PG8_SA(0, 1), cA + hstepA, voffA);
        if (wr == 1) PG8_BAR;
        PG8_WAIT_V(4); PG8_BAR;
        PG8_STAGE(PG8_SB(1, 0), cB + kstep, voffB); PG8_STAGE(PG8_SA(1, 0), cA + kstep, voffA); PG8_STAGE(PG8_SB(1, 1), cB + hstepB + kstep, voffB);
        PG8_WAIT_V(6); PG8_BAR;
    }
    for (;;) {
        const bool has_next = S.next(ui + 1, nxt);
        const char* nA = has_next ? (const char*)g.A + (size_t)nxt.pm * tstepA : cA; const char* nB = has_next ? (const char*)g.Bt + (size_t)nxt.pn * tstepB : cB;
        for (int t = 0; t < nt; t += 2) {
            const bool last = (t == nt - 2);
            const char* a1 = cA + (size_t)(t + 1) * kstep;
            const char* a2 = last ? nA : cA + (size_t)(t + 2) * kstep; const char* b2 = last ? nB : cB + (size_t)(t + 2) * kstep;
            const char* a3 = a2 + kstep; const char* b3 = b2 + kstep;
            if constexpr (SP2) {
            PG8_LDB(B0, 0, 0); PG8_LDB(B1, 0, 1); PG8_SCHED; PG8_LDA(At, 0, 0); PG8_STAGE(PG8_SA(1, 1), a1 + hstepA, voffA);
            PG8_WAIT_V(8); PG8_WAIT_L(0); PG8_BAR; PG8_MMA(0, 0, At, B0); PG8_MMA(0, 1, At, B1); PG8_BAR; PG8_SCHED;
            PG8_LDA(At, 0, 1); PG8_STAGE(PG8_SB(0, 0), b2, voffB); PG8_STAGE(PG8_SB(0, 1), b2 + hstepB, voffB); PG8_STAGE(PG8_SA(0, 0), a2, voffA);
            PG8_WAIT_V(8); PG8_WAIT_L(0); PG8_BAR; PG8_MMA(1, 0, At, B0); PG8_MMA(1, 1, At, B1); PG8_BAR; PG8_SCHED;
            PG8_LDB(B0, 1, 0); PG8_LDB(B1, 1, 1); PG8_SCHED; PG8_LDA(At, 1, 0); PG8_STAGE(PG8_SA(0, 1), a2 + hstepA, voffA);
            PG8_WAIT_V(8); PG8_WAIT_L(0); PG8_BAR; PG8_MMA(0, 0, At, B0); PG8_MMA(0, 1, At, B1); PG8_BAR; PG8_SCHED;
            PG8_LDA(At, 1, 1); PG8_STAGE(PG8_SB(1, 0), b3, voffB); PG8_STAGE(PG8_SB(1, 1), b3 + hstepB, voffB); PG8_STAGE(PG8_SA(1, 0), a3, voffA);
            PG8_WAIT_V(8); PG8_WAIT_L(0); PG8_BAR; PG8_MMA(1, 0, At, B0); PG8_MMA(1, 1, At, B1); PG8_BAR; PG8_SCHED;
            } else {
            PG8_LDB(B0, 0, 0); PG8_SCHED; PG8_LDA(At, 0, 0); PG8_STAGE(PG8_SA(1, 1), a1 + hstepA, voffA);
            PG8_WAIT_L(8); PG8_BAR; PG8_WAIT_L(0); PG8_MMA(0, 0, At, B0); PG8_BAR; PG8_SCHED;
            PG8_LDB(B1, 0, 1); PG8_STAGE(PG8_SB(0, 0), b2, voffB);
            PG8_BAR; PG8_WAIT_L(0); PG8_MMA(0, 1, At, B1); PG8_BAR;
            PG8_LDA(At, 0, 1); PG8_STAGE(PG8_SA(0, 0), a2, voffA);
            PG8_BAR; PG8_WAIT_L(0); PG8_MMA(1, 0, At, B0); PG8_BAR; PG8_SCHED;
            PG8_STAGE(PG8_SB(0, 1), b2 + hstepB, voffB);
            PG8_WAIT_V(6); PG8_BAR; PG8_MMA(1, 1, At, B1); PG8_BAR;
            PG8_LDB(B0, 1, 0); PG8_SCHED; PG8_LDA(At, 1, 0); PG8_STAGE(PG8_SA(0, 1), a2 + hstepA, voffA);
            PG8_WAIT_L(8); PG8_BAR; PG8_WAIT_L(0); PG8_MMA(0, 0, At, B0); PG8_BAR; PG8_SCHED;
            PG8_LDB(B1, 1, 1); PG8_STAGE(PG8_SB(1, 0), b3, voffB);
            PG8_BAR; PG8_WAIT_L(0); PG8_MMA(0, 1, At, B1); PG8_BAR;
            PG8_LDA(At, 1, 1); PG8_STAGE(PG8_SA(1, 0), a3, voffA);
            PG8_BAR; PG8_WAIT_L(0); PG8_MMA(1, 0, At, B0); PG8_BAR; PG8_SCHED;
            PG8_STAGE(PG8_SB(1, 1), b3 + hstepB, voffB);
            PG8_WAIT_V(6); PG8_BAR; PG8_MMA(1, 1, At, B1); PG8_BAR;
            }
        }
        if (wr == 0) PG8_BAR;
        E(acc, cur, wr, wc, fr, fq);
        if (!has_next) break;
#pragma unroll
        for (int a = 0; a < 2; ++a)
#pragma unroll
            for (int b = 0; b < 2; ++b)
#pragma unroll
                for (int m = 0; m < 4; ++m)
#pragma unroll
                    for (int n = 0; n < 2; ++n) acc[a][b][m][n] = (f32x4){0.f, 0.f, 0.f, 0.f};
        cur = nxt; cA = nA; cB = nB; ++ui;
        if (wr == 1) PG8_BAR;
    }
    PG8_WAIT_V(0);
    PG8_BAR;
#undef PG8_SA
#undef PG8_SB
#undef PG8_STAGE
#undef PG8_LDA
#undef PG8_LDB
#undef PG8_MMA
#undef PG8_WAIT_V
#undef PG8_WAIT_L
#undef PG8_BAR
#undef PG8_SCHED
}
}

typedef f32x4 Acc[2][2][4][2];
struct EpiP1 {
    static constexpr bool PERM = true;
    bf16_t *hglu, *Qb, *Kb, *Gt; const float* bgate;
    __device__ __forceinline__ void operator()(const Acc& acc, const pg8::Unit& u, int wr, int wc, int fr, int fq) const {
        const int row0 = u.pm * 256 + wr * 64 + fr, pn = u.pn;
        if (pn < 8) {
            const int col0 = pn * 128 + wc * 32 + 8 * fq;
#pragma unroll
            for (int ai = 0; ai < 2; ++ai)
#pragma unroll
                for (int m = 0; m < 4; ++m) { const f32x4 a0 = acc[ai][0][m][0], a1 = acc[ai][0][m][1], g0 = acc[ai][1][m][0], g1 = acc[ai][1][m][1]; u32x4 w;
                    w.x = pk2(a0[0] * fsigmoid(g0[0]), a0[1] * fsigmoid(g0[1])); w.y = pk2(a0[2] * fsigmoid(g0[2]), a0[3] * fsigmoid(g0[3]));
                    w.z = pk2(a1[0] * fsigmoid(g1[0]), a1[1] * fsigmoid(g1[1])); w.w = pk2(a1[2] * fsigmoid(g1[2]), a1[3] * fsigmoid(g1[3]));
                    *(u32x4*)(hglu + (size_t)(row0 + ai * 128 + m * 16) * CONV_CH + col0) = w; }
        } else if (pn < 16) {
            bf16_t* dst = pn < 12 ? Qb : Kb; const float sc = pn < 12 ? QSCALE : 1.0f; const int col0 = (pn & 3) * 256 + wc * 32 + 8 * fq;
#pragma unroll
            for (int ai = 0; ai < 2; ++ai)
#pragma unroll
                for (int m = 0; m < 4; ++m)
#pragma unroll
                    for (int bj = 0; bj < 2; ++bj) { const f32x4 v0 = acc[ai][bj][m][0] * sc, v1 = acc[ai][bj][m][1] * sc; u32x4 w;
                        w.x = pk2(v0[0], v0[1]); w.y = pk2(v0[2], v0[3]); w.z = pk2(v1[0], v1[1]); w.w = pk2(v1[2], v1[3]);
                        *(u32x4*)(dst + (size_t)(row0 + ai * 128 + m * 16) * 1024 + col0 + bj * 128) = w; }
        } else {
            const int col0 = (pn - 16) * 256 + wc * 32 + 8 * fq;
#pragma unroll
            for (int bj = 0; bj < 2; ++bj) { const f32x4 b0 = *(const f32x4*)(bgate + col0 + bj * 128), b1 = *(const f32x4*)(bgate + col0 + bj * 128 + 4);
#pragma unroll
                for (int ai = 0; ai < 2; ++ai)
#pragma unroll
                    for (int m = 0; m < 4; ++m) { const f32x4 v0 = acc[ai][bj][m][0] + b0, v1 = acc[ai][bj][m][1] + b1; u32x4 w;
                        w.x = pk2(fsigmoid(v0[0]), fsigmoid(v0[1])); w.y = pk2(fsigmoid(v0[2]), fsigmoid(v0[3])); w.z = pk2(fsigmoid(v1[0]), fsigmoid(v1[1])); w.w = pk2(fsigmoid(v1[2]), fsigmoid(v1[3]));
                        *(u32x4*)(Gt + (size_t)(row0 + ai * 128 + m * 16) * 4096 + col0 + bj * 128) = w; } }
        }
    }
};
struct EpiBf16 {
    static constexpr bool PERM = true;
    bf16_t* O; int ldc;
    __device__ __forceinline__ void operator()(const Acc& acc, const pg8::Unit& u, int wr, int wc, int fr, int fq) const {
        const int row0 = u.pm * 256 + wr * 64 + fr, col0 = u.pn * 256 + wc * 32 + 8 * fq;
#pragma unroll
        for (int ai = 0; ai < 2; ++ai)
#pragma unroll
            for (int m = 0; m < 4; ++m)
#pragma unroll
                for (int bj = 0; bj < 2; ++bj) { const f32x4 v0 = acc[ai][bj][m][0], v1 = acc[ai][bj][m][1]; u32x4 w;
                    w.x = pk2(v0[0], v0[1]); w.y = pk2(v0[2], v0[3]); w.z = pk2(v1[0], v1[1]); w.w = pk2(v1[2], v1[3]);
                    *(u32x4*)(O + (size_t)(row0 + ai * 128 + m * 16) * ldc + col0 + bj * 128) = w; }
    }
};
template <int MODE> struct EpiF32 {
    static constexpr bool PERM = false;
    float* T1; const bf16_t* G; bf16_t* OB; const float* X; float* OUT; const float* bias;
    __device__ __forceinline__ void operator()(const Acc& acc, const pg8::Unit& u, int wr, int wc, int fr, int fq) const {
        const int row0 = u.pm * 256 + wr * 64 + fr, col0 = u.pn * 256 + wc * 32 + 4 * fq;
#pragma unroll
        for (int ai = 0; ai < 2; ++ai)
#pragma unroll
            for (int m = 0; m < 4; ++m) { const size_t row = (size_t)(row0 + ai * 128 + m * 16);
#pragma unroll
                for (int bj = 0; bj < 2; ++bj)
#pragma unroll
                    for (int n = 0; n < 2; ++n) { const int col = col0 + bj * 128 + n * 16; const f32x4 a = acc[ai][bj][m][n]; const size_t o = row * DM + col;
                        if constexpr (MODE == 0) { const u32x2 gw_ = *(const u32x2*)(G + row * 4096 + col); *(f32x4*)(T1 + o) = (f32x4){a[0] * bflo(gw_.x), a[1] * bfhi(gw_.x), a[2] * bflo(gw_.y), a[3] * bfhi(gw_.y)}; }
                        if constexpr (MODE == 1) { const u32x2 gw_ = *(const u32x2*)(G + row * 4096 + 2048 + col); const f32x4 t = *(const f32x4*)(T1 + o);
                            u32x2 w; w.x = pk2(t[0] + a[0] * bflo(gw_.x), t[1] + a[1] * bfhi(gw_.x)); w.y = pk2(t[2] + a[2] * bflo(gw_.y), t[3] + a[3] * bfhi(gw_.y)); *(u32x2*)(OB + o) = w; }
                        if constexpr (MODE == 2) { const f32x4 x = *(const f32x4*)(X + o); *(f32x4*)(OUT + o) = x * ALPHA + a; }
                        if constexpr (MODE == 3) { *(f32x4*)(T1 + o) = a; }
                        if constexpr (MODE == 4) { const f32x4 x = *(const f32x4*)(X + o), e = *(const f32x4*)(T1 + o), b = *(const f32x4*)(bias + col);
                            *(f32x4*)(OUT + o) = (f32x4){x[0] + fsigmoid(a[0] + b[0]) * e[0], x[1] + fsigmoid(a[1] + b[1]) * e[1], x[2] + fsigmoid(a[2] + b[2]) * e[2], x[3] + fsigmoid(a[3] + b[3]) * e[3]}; }
                    } }
    }
};

struct Args { const float* in[N_IN]; float* out; unsigned char* ws; int ph_lo, ph_hi; };
struct Frame { LAS unsigned char* lds; int tid, lane, wave, vcu, G; const float* const* in; unsigned char* ws; float* out; };
__device__ __forceinline__ float wave_sum(float v) {
#pragma unroll
    for (int o = 1; o < 64; o <<= 1) v += __shfl_xor(v, o);
    return v;
}
__device__ __forceinline__ void p0_transpose_item(const float* W, int K, int N, bf16_t* WT, int dst_row0, int k0, int n0, LAS float* scr, int lane) {
#pragma unroll 8
    for (int i = 0; i < 32; ++i) { const int kk = 2 * i + (lane >> 5); scr[kk * 33 + (lane & 31)] = W[(size_t)(k0 + kk) * N + n0 + (lane & 31)]; }
    LDS_WAIT(); asm volatile("" ::: "memory");
    const int c = lane & 7;
#pragma unroll
    for (int j = 0; j < 4; ++j) { const int n = (lane >> 3) + 8 * j; const LAS float* s = scr + (8 * c) * 33 + n;
        u32x4 o; o.x = pk2(s[0 * 33], s[1 * 33]); o.y = pk2(s[2 * 33], s[3 * 33]); o.z = pk2(s[4 * 33], s[5 * 33]); o.w = pk2(s[6 * 33], s[7 * 33]);
        *(GAS u32x4*)(WT + (size_t)(dst_row0 + n) * K + k0 + 8 * c) = o; }
    LDS_WAIT(); asm volatile("" ::: "memory");
}
__device__ __forceinline__ int win_dst_row(int col) {
    if (col < 1024) return (col >> 7) * 256 + (col & 127);
    if (col < 2048) return ((col - 1024) >> 7) * 256 + 128 + (col & 127);
    if (col < 4096) return col;
    if (col < 5120) return col + 4096;
    return col - 1024;
}
__device__ __forceinline__ void p0_transpose_matrix(Frame& F, const float* W, int K, int N, bf16_t* WT, bool is_win, int& it0, LAS float* scr) {
    const int gw = F.vcu * NWAVES + F.wave, NGW = F.G * NWAVES, nblk = N / 32, nitems = (K / 64) * nblk;
    int first = gw - (it0 % NGW); if (first < 0) first += NGW;
    for (int r = first; r < nitems; r += NGW) { const int kb = r / nblk, nb = r % nblk, n0 = 32 * nb; p0_transpose_item(W, K, N, WT, is_win ? win_dst_row(n0) : n0, 64 * kb, n0, scr, F.lane); }
    it0 += nitems;
}
__device__ __forceinline__ void p0_cvt(Frame& F, const float* src, bf16_t* dst, size_t n) {
    const size_t gt = (size_t)F.vcu * NTHREADS + F.tid, NGT = (size_t)F.G * NTHREADS;
    for (size_t i = gt * 8; i < n; i += NGT * 8) { const f32x4 a = *(const GAS f32x4*)(src + i), b = *(const GAS f32x4*)(src + i + 4);
        u32x4 w; w.x = pk2(a[0], a[1]); w.y = pk2(a[2], a[3]); w.z = pk2(b[0], b[1]); w.w = pk2(b[2], b[3]); *(GAS u32x4*)(dst + i) = w; }
}
__device__ __forceinline__ void p0_prologue(Frame& F) {
    LAS float* scr = (LAS float*)(F.lds + F.wave * 16384);
    int it0 = 0;
    p0_transpose_matrix(F, F.in[I_WIN], DM, IN_COLS, (bf16_t*)(F.ws + WS_WINT), true, it0, scr);
    p0_transpose_matrix(F, F.in[I_CWOUT], CONV_CH, DM, (bf16_t*)(F.ws + WS_WCT), false, it0, scr);
    p0_transpose_matrix(F, F.in[I_AWO], 1024, DM, (bf16_t*)(F.ws + WS_WOT), false, it0, scr);
    p0_transpose_matrix(F, F.in[I_WOUT], DM, DM, (bf16_t*)(F.ws + WS_WOUTT), false, it0, scr);
    p0_transpose_matrix(F, F.in[I_PWQ], DM, DM, (bf16_t*)(F.ws + WS_WQT), false, it0, scr);
    p0_transpose_matrix(F, F.in[I_PLEWG], DM, DM, (bf16_t*)(F.ws + WS_WPGT), false, it0, scr);
    p0_transpose_matrix(F, F.in[I_PLEWP], P_DIM, DM, (bf16_t*)(F.ws + WS_WPT), false, it0, scr);
    p0_cvt(F, F.in[I_X], (bf16_t*)(F.ws + WS_XB), (size_t)MTOK * DM);
    p0_cvt(F, F.in[I_P], (bf16_t*)(F.ws + WS_PB), (size_t)MTOK * P_DIM);
    p0_cvt(F, F.in[I_PSK], (bf16_t*)(F.ws + WS_SK), (size_t)PH * 2 * PNK * PHALF);
    p0_cvt(F, F.in[I_PU], (bf16_t*)(F.ws + WS_UB), (size_t)NEXP * DM);
    p0_cvt(F, F.in[I_PV], (bf16_t*)(F.ws + WS_VB), (size_t)NEXP * DM);
}


__device__ __forceinline__ void ln_row_2048(const float* zrow, const float* g, const float* b, float* yf, bf16_t* yb, int lane) {
    const GAS f32x4* zr = (const GAS f32x4*)zrow + lane;
    f32x4 v[8]; float s = 0.f;
#pragma unroll
    for (int j = 0; j < 8; ++j) { v[j] = zr[64 * j]; s += (v[j].x + v[j].y) + (v[j].z + v[j].w); }
    const float mean = wave_sum(s) * (1.f / DM); float s2 = 0.f;
#pragma unroll
    for (int j = 0; j < 8; ++j) { v[j] = v[j] - mean; s2 += (v[j].x * v[j].x + v[j].y * v[j].y) + (v[j].z * v[j].z + v[j].w * v[j].w); }
    const float rstd = __builtin_amdgcn_rsqf(wave_sum(s2) * (1.f / DM) + LN_EPS);
#pragma unroll
    for (int j = 0; j < 8; ++j) { const f32x4 gg = ((const GAS f32x4*)g + lane)[64 * j], bb = ((const GAS f32x4*)b + lane)[64 * j]; const f32x4 y = v[j] * rstd * gg + bb;
        ((GAS f32x4*)yf + lane)[64 * j] = y; u32x2 w; w.x = pk2(y.x, y.y); w.y = pk2(y.z, y.w); ((GAS u32x2*)yb + lane)[64 * j] = w; }
}


__device__ __forceinline__ float dot2_bf16(unsigned w, unsigned x, float acc) { return __builtin_amdgcn_fdot2_f32_bf16(__builtin_bit_cast(bf16x2_t, w), __builtin_bit_cast(bf16x2_t, x), acc, false); }
__device__ __forceinline__ float dpp_row_shr(float v, int n) {
    const int iv = __builtin_bit_cast(int, v); int r;
    switch (n) { case 1: r = __builtin_amdgcn_update_dpp(0, iv, 0x111, 0xf, 0xf, true); break; case 2: r = __builtin_amdgcn_update_dpp(0, iv, 0x112, 0xf, 0xf, true); break;
                 case 4: r = __builtin_amdgcn_update_dpp(0, iv, 0x114, 0xf, 0xf, true); break; default: r = __builtin_amdgcn_update_dpp(0, iv, 0x118, 0xf, 0xf, true); break; }
    return __builtin_bit_cast(float, r);
}
__device__ __forceinline__ float wave_total(float v) {
    v += dpp_row_shr(v, 1); v += dpp_row_shr(v, 2); v += dpp_row_shr(v, 4); v += dpp_row_shr(v, 8);
    v += __builtin_bit_cast(float, __builtin_amdgcn_update_dpp(0, __builtin_bit_cast(int, v), 0x142, 0xa, 0xf, false));
    v += __builtin_bit_cast(float, __builtin_amdgcn_update_dpp(0, __builtin_bit_cast(int, v), 0x143, 0xc, 0xf, false));
    return __builtin_bit_cast(float, __builtin_amdgcn_readlane(__builtin_bit_cast(int, v), 63));
}
__device__ __forceinline__ float gelu_fast(float h) {
    const float u = 1.5957691216057308f * (h + 0.044715f * h * h * h);
    return h * __builtin_amdgcn_rcpf(1.0f + __builtin_amdgcn_exp2f(-LOG2E * u));
}
__device__ __forceinline__ void p8_token(const bf16_t* x1b_row, const float* x1f_row, const int* ids, const float* gwt, const bf16_t* Ub, const bf16_t* Vb,
                                         const float* g2, const float* b2, float* x2f_row, bf16_t* x2b_row, int lane) {
    const int id_lo = ids[lane], id_hi = ids[lane + 64]; const float g_lo = gwt[lane], g_hi = gwt[lane + 64];
    u32x4 xq[4];
#pragma unroll
    for (int i = 0; i < 4; ++i) xq[i] = ((const GAS u32x4*)x1b_row)[lane + 64 * i];
    float w_lo = 0.f, w_hi = 0.f;
    for (int half = 0; half < 2; ++half) {
        const int idr = half ? id_hi : id_lo; const float gr = half ? g_hi : g_lo; float wr_ = 0.f;
        for (int jb = 0; jb < 8; ++jb) {
            u32x4 r[8][4];
#pragma unroll
            for (int jj = 0; jj < 8; ++jj) { const int id = __builtin_amdgcn_readlane(idr, jb * 8 + jj); const GAS u32x4* rp = (const GAS u32x4*)(Ub + (size_t)id * DM) + lane;
#pragma unroll
                for (int i = 0; i < 4; ++i) r[jj][i] = rp[64 * i]; }
#pragma unroll
            for (int jj = 0; jj < 8; ++jj) { float a0 = 0.f, a1 = 0.f, a2 = 0.f, a3 = 0.f;
#pragma unroll
                for (int i = 0; i < 4; ++i) { a0 = dot2_bf16(r[jj][i].x, xq[i].x, a0); a1 = dot2_bf16(r[jj][i].y, xq[i].y, a1); a2 = dot2_bf16(r[jj][i].z, xq[i].z, a2); a3 = dot2_bf16(r[jj][i].w, xq[i].w, a3); }
                const float h = wave_total((a0 + a1) + (a2 + a3));
                const float gj = __builtin_bit_cast(float, __builtin_amdgcn_readlane(__builtin_bit_cast(int, gr), jb * 8 + jj));
                const float wv = gj * gelu_fast(h);
                wr_ = (lane == jb * 8 + jj) ? wv : wr_; }
        }
        if (half) w_hi = wr_; else w_lo = wr_;
    }
    float acc[32];
#pragma unroll
    for (int k = 0; k < 32; ++k) acc[k] = 0.f;
    for (int half = 0; half < 2; ++half) {
        const int idr = half ? id_hi : id_lo; const float wr_ = half ? w_hi : w_lo;
        for (int jb = 0; jb < 16; ++jb) {
            u32x4 r[4][4];
#pragma unroll
            for (int jj = 0; jj < 4; ++jj) { const int id = __builtin_amdgcn_readlane(idr, jb * 4 + jj); const GAS u32x4* rp = (const GAS u32x4*)(Vb + (size_t)id * DM) + lane;
#pragma unroll
                for (int i = 0; i < 4; ++i) r[jj][i] = rp[64 * i]; }
#pragma unroll
            for (int jj = 0; jj < 4; ++jj) { const float w = __builtin_bit_cast(float, __builtin_amdgcn_readlane(__builtin_bit_cast(int, wr_), jb * 4 + jj));
#pragma unroll
                for (int i = 0; i < 4; ++i) { const u32x4 q = r[jj][i];
                    acc[8 * i + 0] = fmaf(w, bflo(q.x), acc[8 * i + 0]); acc[8 * i + 1] = fmaf(w, bfhi(q.x), acc[8 * i + 1]); acc[8 * i + 2] = fmaf(w, bflo(q.y), acc[8 * i + 2]); acc[8 * i + 3] = fmaf(w, bfhi(q.y), acc[8 * i + 3]);
                    acc[8 * i + 4] = fmaf(w, bflo(q.z), acc[8 * i + 4]); acc[8 * i + 5] = fmaf(w, bfhi(q.z), acc[8 * i + 5]); acc[8 * i + 6] = fmaf(w, bflo(q.w), acc[8 * i + 6]); acc[8 * i + 7] = fmaf(w, bfhi(q.w), acc[8 * i + 7]); } }
        }
    }
    float s = 0.f;
#pragma unroll
    for (int i = 0; i < 4; ++i) { const GAS f32x4* xp = (const GAS f32x4*)x1f_row + 2 * (lane + 64 * i); const f32x4 xa = xp[0], xb = xp[1];
        acc[8 * i + 0] += ALPHA * xa.x; acc[8 * i + 1] += ALPHA * xa.y; acc[8 * i + 2] += ALPHA * xa.z; acc[8 * i + 3] += ALPHA * xa.w;
        acc[8 * i + 4] += ALPHA * xb.x; acc[8 * i + 5] += ALPHA * xb.y; acc[8 * i + 6] += ALPHA * xb.z; acc[8 * i + 7] += ALPHA * xb.w; }
#pragma unroll
    for (int k = 0; k < 32; ++k) s += acc[k];
    const float mean = wave_total(s) * (1.f / DM); float s2 = 0.f;
#pragma unroll
    for (int k = 0; k < 32; ++k) { acc[k] -= mean; s2 += acc[k] * acc[k]; }
    const float rstd = __builtin_amdgcn_rsqf(wave_total(s2) * (1.f / DM) + LN_EPS);
#pragma unroll
    for (int i = 0; i < 4; ++i) { const int c = 2 * (lane + 64 * i); const f32x4 ga = ((const GAS f32x4*)g2)[c], gb = ((const GAS f32x4*)g2)[c + 1], ba = ((const GAS f32x4*)b2)[c], bb = ((const GAS f32x4*)b2)[c + 1];
        const f32x4 ya = {acc[8 * i + 0] * rstd * ga.x + ba.x, acc[8 * i + 1] * rstd * ga.y + ba.y, acc[8 * i + 2] * rstd * ga.z + ba.z, acc[8 * i + 3] * rstd * ga.w + ba.w};
        const f32x4 yb = {acc[8 * i + 4] * rstd * gb.x + bb.x, acc[8 * i + 5] * rstd * gb.y + bb.y, acc[8 * i + 6] * rstd * gb.z + bb.z, acc[8 * i + 7] * rstd * gb.w + bb.w};
        ((GAS f32x4*)x2f_row)[c] = ya; ((GAS f32x4*)x2f_row)[c + 1] = yb;
        u32x4 w; w.x = pk2(ya.x, ya.y); w.y = pk2(ya.z, ya.w); w.z = pk2(yb.x, yb.y); w.w = pk2(yb.z, yb.w); ((GAS u32x4*)x2b_row)[lane + 64 * i] = w; }
}


__device__ __forceinline__ int f2key(float v) { const int b = __builtin_bit_cast(int, v); return b ^ ((b >> 31) & 0x7fffffff); }
__device__ __forceinline__ float key2f(int k) { const int b = k ^ ((k >> 31) & 0x7fffffff); return __builtin_bit_cast(float, b); }
__device__ __forceinline__ void cmpx(int& a, int& b) { const int mx = a > b ? a : b, mn = a > b ? b : a; a = mx; b = mn; }
template <int N> __device__ __forceinline__ void bitonic_merge_desc(int (&k)[N]) {
#pragma unroll
    for (int stride = N / 2; stride > 0; stride >>= 1)
#pragma unroll
        for (int i = 0; i < N; ++i) { const int j = i ^ stride; if (j > i) cmpx(k[i], k[j]); }
}
template <int N> __device__ __forceinline__ void bitonic_sort_desc(int (&k)[N]) {
#pragma unroll
    for (int size = 2; size <= N; size <<= 1)
#pragma unroll
        for (int stride = size >> 1; stride > 0; stride >>= 1)
#pragma unroll
            for (int i = 0; i < N; ++i) { const int j = i ^ stride; if (j > i) { if ((i & size) == 0 || size == N) cmpx(k[i], k[j]); else cmpx(k[j], k[i]); } }
}
__device__ __forceinline__ void top16_merge(int (&a)[16], const int (&b)[16]) {
#pragma unroll
    for (int i = 0; i < 16; ++i) a[i] = a[i] > b[15 - i] ? a[i] : b[15 - i];
    bitonic_merge_desc<16>(a);
}
__device__ __forceinline__ void top16_of_64(int (&g0)[16], int (&g1)[16], int (&g2)[16], int (&g3)[16]) {
    bitonic_sort_desc<16>(g0); bitonic_sort_desc<16>(g1); bitonic_sort_desc<16>(g2); bitonic_sort_desc<16>(g3);
    top16_merge(g0, g1); top16_merge(g2, g3); top16_merge(g0, g2);
}
__device__ __forceinline__ void p7_tile(const bf16_t* qp, const bf16_t* SK, int* ids, float* gwt, int tok0, int h, LAS int* scr  , int lane) {
    const int r32 = lane & 31, hi = lane >> 5;
    int top[2][16];
#pragma unroll
    for (int c = 0; c < 2; ++c) {
        const int hc = h * 2 + c;
        f32x16 acc[4];
#pragma unroll
        for (int nb = 0; nb < 4; ++nb) acc[nb] = f32x16{};
        const bf16_t* qrow = qp + (size_t)(tok0 + r32) * DM + hc * 128 + 8 * hi;
        const bf16_t* krow = SK + ((size_t)hc * 128 + r32) * 128 + 8 * hi;
#pragma unroll 2
        for (int ks = 0; ks < 8; ++ks) {
            const bf16x8 qf = *(const GAS bf16x8*)(qrow + 16 * ks);
#pragma unroll
            for (int nb = 0; nb < 4; ++nb) { const bf16x8 kf = *(const GAS bf16x8*)(krow + (size_t)nb * 32 * 128 + 16 * ks); acc[nb] = __builtin_amdgcn_mfma_f32_32x32x16_bf16(kf, qf, acc[nb], 0, 0, 0); }
        }
        int g[4][16];
#pragma unroll
        for (int nb = 0; nb < 4; ++nb)
#pragma unroll
            for (int r = 0; r < 16; ++r) { const int n = 32 * nb + 8 * (r >> 2) + 4 * hi + (r & 3); g[nb][r] = (f2key(acc[nb][r]) & ~0x7f) | (127 - n); }
        top16_of_64(g[0], g[1], g[2], g[3]);
        int lo_[16], hi_[16];
#pragma unroll
        for (int i = 0; i < 16; ++i) { auto rr = __builtin_amdgcn_permlane32_swap((unsigned)g[0][i], (unsigned)g[0][i], false, false); lo_[i] = (int)rr[0]; hi_[i] = (int)rr[1]; }
        top16_merge(lo_, hi_);
#pragma unroll
        for (int i = 0; i < 16; ++i) top[c][i] = lo_[i];
    }
#pragma unroll
    for (int c = 0; c < 2; ++c)
#pragma unroll
        for (int i = 0; i < 16; ++i) scr[(16 * c + i) * 64 + lane] = 127 - (top[c][i] & 0x7f);
    int cg[4][16];
    {
        int cnt = 0;
#pragma unroll
        for (int i = 0; i < 16; ++i)
#pragma unroll
            for (int j = 0; j < 16; ++j) if ((i + 1) * (j + 1) <= 16) {
                const float sum = key2f(top[0][i] & ~0x7f) + key2f(top[1][j] & ~0x7f);
                cg[cnt >> 4][cnt & 15] = (f2key(sum) & ~0xff) | (255 - ((i << 4) | j)); ++cnt; }
#pragma unroll
        for (int q = 50; q < 64; ++q) cg[q >> 4][q & 15] = (int)0x80000000;
    }
    top16_of_64(cg[0], cg[1], cg[2], cg[3]);
    LDS_WAIT();
    float e[16]; float sum = 0.f; const float smax = key2f(cg[0][0] & ~0xff);
#pragma unroll
    for (int r = 0; r < 16; ++r) { e[r] = __builtin_amdgcn_exp2f((key2f(cg[0][r] & ~0xff) - smax) * LOG2E); sum += e[r]; }
    const float inv = __builtin_amdgcn_rcpf(sum);
    if (hi == 0) {
        int* ip = ids + (size_t)(tok0 + r32) * 128 + h * 16; float* gp = gwt + (size_t)(tok0 + r32) * 128 + h * 16;
#pragma unroll
        for (int r = 0; r < 16; ++r) { const int pay = 255 - (cg[0][r] & 0xff); const int i0 = scr[(pay >> 4) * 64 + lane], i1 = scr[(16 + (pay & 15)) * 64 + lane];
            ip[r] = i0 * PNK + i1; gp[r] = e[r] * inv; }
    }
    LDS_WAIT();
}


__device__ __forceinline__ float dpp_scan64(float v) {
    v += dpp_row_shr(v, 1); v += dpp_row_shr(v, 2); v += dpp_row_shr(v, 4); v += dpp_row_shr(v, 8);
    v += __builtin_bit_cast(float, __builtin_amdgcn_update_dpp(0, __builtin_bit_cast(int, v), 0x142, 0xa, 0xf, false));
    v += __builtin_bit_cast(float, __builtin_amdgcn_update_dpp(0, __builtin_bit_cast(int, v), 0x143, 0xc, 0xf, false));
    return v;
}
template <int R> __device__ __forceinline__ void conv_rows(f32x2 (&y)[16], const f32x2 (&w)[31], const unsigned (&xin)[46]) {
    const f32x2 xv = {bflo(xin[R]), bfhi(xin[R])};
    constexpr int tlo = R - 30 < 0 ? 0 : R - 30, thi = R < 16 ? R : 15;
#pragma unroll
    for (int t = tlo; t <= thi; ++t) y[t] = y[t] + w[R - t] * xv;
    if constexpr (R + 1 < 46) conv_rows<R + 1>(y, w, xin);
}
__device__ __forceinline__ void p2_conv_item(const bf16_t* hglu, const float* dww, const float* dwb, const float* lng, const float* lnb, bf16_t* hc, int tok0, LAS float* red  , int tid) {
    const int c0 = 2 * tid, s0 = tok0 % SEQ, lane = tid & 63, wave = tid >> 6;
    unsigned xin[46];
#pragma unroll
    for (int r = 0; r < 46; ++r) { const bool ok = (s0 - 30 + r) >= 0; xin[r] = ok ? *(const GAS unsigned*)(hglu + (size_t)(tok0 - 30 + r) * CONV_CH + c0) : 0u; }
    f32x2 w[31];
#pragma unroll
    for (int j = 0; j < 31; ++j) w[j] = *(const GAS f32x2*)(dww + j * CONV_CH + c0);
    const f32x2 bias = *(const GAS f32x2*)(dwb + c0);
    f32x2 y[16];
#pragma unroll
    for (int t = 0; t < 16; ++t) y[t] = bias;
    conv_rows<0>(y, w, xin);
#pragma unroll
    for (int t = 0; t < 16; ++t) { const float ps = dpp_scan64(y[t].x + y[t].y), pq = dpp_scan64(y[t].x * y[t].x + y[t].y * y[t].y);
        if (lane == 63) { red[(2 * t) * 8 + wave] = ps; red[(2 * t + 1) * 8 + wave] = pq; } }
    LDS_WAIT(); __syncthreads();
    if (tid < 32) { float a = 0.f;
#pragma unroll
        for (int k = 0; k < 8; ++k) a += red[tid * 8 + k];
        red[256 + tid] = a; }
    LDS_WAIT(); __syncthreads();
    const f32x2 g = *(const GAS f32x2*)(lng + c0), bb = *(const GAS f32x2*)(lnb + c0);
#pragma unroll
    for (int t = 0; t < 16; ++t) { const float mean = red[256 + 2 * t] * (1.f / CONV_CH), ex2 = red[256 + 2 * t + 1] * (1.f / CONV_CH);
        const float rstd = __builtin_amdgcn_rsqf(ex2 - mean * mean + LN_EPS);
        const float v0 = (y[t].x - mean) * rstd * g.x + bb.x, v1 = (y[t].y - mean) * rstd * g.y + bb.y;
        *(GAS unsigned*)(hc + (size_t)(tok0 + t) * CONV_CH + c0) = pk2(v0 * fsigmoid(v0), v1 * fsigmoid(v1)); }
    __syncthreads();
}

constexpr int AT_KBYTES = 8192, AT_VPITCH = 136, AT_VBYTES = 128 * AT_VPITCH, AT_BUF = 2 * AT_KBYTES + AT_VBYTES;
constexpr int AT_WSF = 2 * AT_BUF;
constexpr int AT_XCH = 0;
static_assert(AT_WSF + 8 * 128 <= RING_BYTES && 4 * 32 * 128 * 4 <= AT_WSF, "attention LDS map");
__device__ __forceinline__ int crow(int r, int hi) { return (r & 3) + 8 * (r >> 2) + 4 * hi; }
__device__ __forceinline__ void p2_attn_unit(const bf16_t* Qb, const bf16_t* Kb, const bf16_t* VT, bf16_t* on, const float* subg, float lam, int b, int h, int qb, LAS unsigned char* lds, int tid) {
    const int lane = tid & 63, r32 = lane & 31, hi = lane >> 5, wid = __builtin_amdgcn_readfirstlane(tid >> 6), map = wid >> 2, wq = wid & 3;
    const size_t rowb = (size_t)b * SEQ; const int q0 = 128 * qb + 32 * wq;
    const int NT = 2 * (qb + 1);
    const float sl = __builtin_amdgcn_exp2f(-(float)(h + 1)) * LOG2E;
    const bf16_t* kg[2]; int kl[2]; const bf16_t* vg[2]; int vl[2];
#pragma unroll
    for (int i = 0; i < 2; ++i) { const int p = tid + 512 * i, mp = p >> 9, key = p & 63, ch = (p >> 6) & 7;
        kg[i] = Kb + (rowb + key) * 1024 + h * 128 + mp * 64 + 8 * ch; kl[i] = mp * AT_KBYTES + ch * 1024 + key * 16;
        const int row = p >> 3, vc = p & 7; vg[i] = VT + (size_t)(h * 128 + row) * MTOK + rowb + 8 * vc; vl[i] = 2 * AT_KBYTES + row * AT_VPITCH + vc * 16; }
    u32x4 ks[2], vs[2];
#define AT_LOAD(t) do { _Pragma("unroll") for (int i_ = 0; i_ < 2; ++i_) { ks[i_] = *(const GAS u32x4*)(kg[i_] + (size_t)(t) * 64 * 1024); vs[i_] = *(const GAS u32x4*)(vg[i_] + (t) * 64); } } while (0)
#define AT_STORE(bufo) do { _Pragma("unroll") for (int i_ = 0; i_ < 2; ++i_) { *(LAS u32x4*)(lds + (bufo) + kl[i_]) = ks[i_]; \
        *(LAS u32x2*)(lds + (bufo) + vl[i_]) = (u32x2){vs[i_].x, vs[i_].y}; *(LAS u32x2*)(lds + (bufo) + vl[i_] + 8) = (u32x2){vs[i_].z, vs[i_].w}; } } while (0)
    AT_LOAD(0);
    bf16x8 qr[4];
#pragma unroll
    for (int d0 = 0; d0 < 4; ++d0) qr[d0] = *(const GAS bf16x8*)(Qb + (rowb + q0 + r32) * 1024 + h * 128 + map * 64 + 16 * d0 + 8 * hi);
    f32x16 o[4];
#pragma unroll
    for (int d0 = 0; d0 < 4; ++d0) o[d0] = f32x16{};
    float mrun = 0.f, lsum = 0.f;
    LAS float* wsf = (LAS float*)(lds + AT_WSF) + wid * 32;
    AT_STORE(0);
    LDS_WAIT(); __syncthreads();
    for (int t = 0; t < NT; ++t) {
        const int bufo = (t & 1) * AT_BUF;
        if (t + 1 < NT) AT_LOAD(t + 1);
        f32x16 x[2];
        { const float base = sl * (float)(64 * t + 4 * hi) - mrun;
#pragma unroll
          for (int r = 0; r < 16; ++r) { x[0][r] = fmaf(sl, (float)crow(r, 0), base); x[1][r] = fmaf(sl, (float)(crow(r, 0) + 32), base); } }
        const LAS unsigned char* kb_ = lds + bufo + map * AT_KBYTES + hi * 1024 + r32 * 16;
#pragma unroll
        for (int d0 = 0; d0 < 4; ++d0) {
            const bf16x8 k0 = *(const LAS bf16x8*)(kb_ + d0 * 2048), k1 = *(const LAS bf16x8*)(kb_ + d0 * 2048 + 512);
            x[0] = __builtin_amdgcn_mfma_f32_32x32x16_bf16(k0, qr[d0], x[0], 0, 0, 0);
            x[1] = __builtin_amdgcn_mfma_f32_32x32x16_bf16(k1, qr[d0], x[1], 0, 0, 0);
        }
        if (t >= NT - 2) {
            const int qrel = 32 * wq + r32, kb0 = 64 * (t - (NT - 2));
#pragma unroll
            for (int r = 0; r < 16; ++r) { const int kr = kb0 + crow(r, hi); if (kr > qrel) x[0][r] = -INFINITY; if (kr + 32 > qrel) x[1][r] = -INFINITY; }
        }
        float rm = fmaxf(x[0][0], x[1][0]);
#pragma unroll
        for (int r = 1; r < 16; ++r) rm = fmaxf(rm, fmaxf(x[0][r], x[1][r]));
        { auto rr = __builtin_amdgcn_permlane32_swap(__float_as_uint(rm), __float_as_uint(rm), false, false); rm = fmaxf(__uint_as_float(rr[0]), __uint_as_float(rr[1])); }
        const bool resc = (t == 0) || __any(rm > 6.0f);
        if (resc) {
            const float dl = (t == 0) ? rm : fmaxf(rm, 0.f); mrun += dl;
#pragma unroll
            for (int r = 0; r < 16; ++r) { x[0][r] -= dl; x[1][r] -= dl; }
            if (t > 0) { const float f = __builtin_amdgcn_exp2f(-dl); lsum *= f; if (hi == 0) wsf[r32] = f; LDS_WAIT();
#pragma unroll
                for (int r = 0; r < 16; ++r) { const float fr_ = wsf[crow(r, hi)];
#pragma unroll
                    for (int d0 = 0; d0 < 4; ++d0) o[d0][r] *= fr_; } }
        }
        u32x4 pa[4];
#pragma unroll
        for (int kb = 0; kb < 2; ++kb) {
#pragma unroll
            for (int r = 0; r < 16; ++r) { x[kb][r] = __builtin_amdgcn_exp2f(x[kb][r]); lsum += x[kb][r]; }
#pragma unroll
            for (int sp = 0; sp < 2; ++sp) pa[2 * kb + sp] = (u32x4){pk2(x[kb][8 * sp + 0], x[kb][8 * sp + 1]), pk2(x[kb][8 * sp + 2], x[kb][8 * sp + 3]), pk2(x[kb][8 * sp + 4], x[kb][8 * sp + 5]), pk2(x[kb][8 * sp + 6], x[kb][8 * sp + 7])};
        }
        const LAS unsigned char* vb_ = lds + bufo + 2 * AT_KBYTES + r32 * AT_VPITCH + hi * 8;
#pragma unroll
        for (int d0 = 0; d0 < 4; ++d0)
#pragma unroll
            for (int s_ = 0; s_ < 4; ++s_) { const u32x2 lo = *(const LAS u32x2*)(vb_ + d0 * 32 * AT_VPITCH + s_ * 32), hh = *(const LAS u32x2*)(vb_ + d0 * 32 * AT_VPITCH + s_ * 32 + 16);
                const u32x4 vf = {lo.x, lo.y, hh.x, hh.y};
                o[d0] = __builtin_amdgcn_mfma_f32_32x32x16_bf16(__builtin_bit_cast(bf16x8, pa[s_]), __builtin_bit_cast(bf16x8, vf), o[d0], 0, 0, 0); }
        if (t + 1 < NT) AT_STORE(((t + 1) & 1) * AT_BUF);
        LDS_WAIT(); __syncthreads();
    }
    { auto rr = __builtin_amdgcn_permlane32_swap(__float_as_uint(lsum), __float_as_uint(lsum), false, false); lsum = __uint_as_float(rr[0]) + __uint_as_float(rr[1]); }
    if (hi == 0) wsf[r32] = ((map == 0) ? 1.0f : lam) / lsum;
    LDS_WAIT();
#pragma unroll
    for (int r = 0; r < 16; ++r) { const float il = wsf[crow(r, hi)];
#pragma unroll
        for (int d0 = 0; d0 < 4; ++d0) o[d0][r] *= il; }
    LAS float* xch = (LAS float*)(lds + AT_XCH) + wq * (32 * 128);
    if (map == 1) {
#pragma unroll
        for (int r = 0; r < 16; ++r)
#pragma unroll
            for (int d0 = 0; d0 < 4; ++d0) xch[crow(r, hi) * 128 + 32 * d0 + r32] = o[d0][r];
    }
    LDS_WAIT(); __syncthreads();
    if (map == 0) {
        float ss[16];
#pragma unroll
        for (int r = 0; r < 16; ++r) { float a = 0.f;
#pragma unroll
            for (int d0 = 0; d0 < 4; ++d0) { o[d0][r] -= xch[crow(r, hi) * 128 + 32 * d0 + r32]; a += o[d0][r] * o[d0][r]; }
            ss[r] = a; }
#pragma unroll
        for (int r = 0; r < 16; ++r) { float a = ss[r]; a += __shfl_xor(a, 1); a += __shfl_xor(a, 2); a += __shfl_xor(a, 4); a += __shfl_xor(a, 8); a += __shfl_xor(a, 16);
            ss[r] = __builtin_amdgcn_rsqf(a * (1.f / 128.f) + LN_EPS) * (1.0f - LAM_INIT); }
        float gsub[4];
#pragma unroll
        for (int d0 = 0; d0 < 4; ++d0) gsub[d0] = subg[32 * d0 + r32];
#pragma unroll
        for (int r = 0; r < 16; ++r) { bf16_t* orow = on + (rowb + q0 + crow(r, hi)) * 1024 + h * 128 + r32;
#pragma unroll
            for (int d0 = 0; d0 < 4; ++d0) orow[32 * d0] = (bf16_t)f2bf(o[d0][r] * ss[r] * gsub[d0]); }
    }
    __syncthreads();
#undef AT_LOAD
#undef AT_STORE
}

constexpr int CW_BAR = 4096;
constexpr size_t CTL_ZERO_BYTES = 64 * 1024;
enum { PH_P0 = 0, PH_P1, PH_P2, PH_P3, PH_P4, PH_P5, PH_P6, PH_P7, PH_P8, PH_P9, PH_END };

__global__ void __launch_bounds__(NTHREADS, 2) mk_fwd(Args args) {
    extern __shared__ __attribute__((aligned(16))) unsigned char lds_raw[];
    Frame F;
    F.lds = (LAS unsigned char*)lds_raw;
    F.tid = threadIdx.x; F.lane = F.tid & 63; F.wave = __builtin_amdgcn_readfirstlane(F.tid >> 6);
    F.G = gridDim.x; { const int bx = blockIdx.x; F.vcu = (F.G % 8 == 0) ? (bx % 8) * (F.G / 8) + bx / 8 : bx; }
    F.in = args.in; F.ws = args.ws; F.out = args.out;
    volatile LAS unsigned* MISC = (volatile LAS unsigned*)(F.lds + MISC_OFF);
    for (int u = F.tid; u < (LDS_BYTES - MISC_OFF) / 4; u += NTHREADS) MISC[u] = 0u;
    __syncthreads();
    const int lo = args.ph_lo, hi = args.ph_hi;
    XcdBarrier bar; bar.bar = (unsigned*)(F.ws + WS_CTL) + CW_BAR; bar.x = 0; bar.st = nullptr;
    if (hi - lo > 1) bar = xcd_barrier_post((unsigned*)(F.ws + WS_CTL) + CW_BAR, MISC + 8);
#define IN(k) (lo <= (k) && (k) < hi)
#define SEAM(k) do { if (IN(k) && IN((k) + 1)) xcd_barrier(bar); } while (0)
    unsigned char* ws = F.ws;
    if (IN(PH_P0)) { p0_prologue(F); SEAM(PH_P0); }
    if (IN(PH_P1)) {
        { pg8::Gemm g{(const bf16_t*)(ws + WS_XB), (const bf16_t*)(ws + WS_WINT), DM, DM, DM}; pg8::StaticOrder S; S.init(MTOK, 8192, F.G, (int)blockIdx.x);
          EpiP1 E{(bf16_t*)(ws + WS_HGLU), (bf16_t*)(ws + WS_QB), (bf16_t*)(ws + WS_KB), (bf16_t*)(ws + WS_GT), F.in[I_BGATE]};
          pg8::gemm_phase<EpiP1>(F.lds, g, S, E); }
        { pg8::Gemm g{(const bf16_t*)(ws + WS_WINT) + (size_t)8192 * DM, (const bf16_t*)(ws + WS_XB), DM, DM, DM}; pg8::StaticOrder S; S.init(1024, MTOK, F.G, (int)blockIdx.x);
          EpiBf16 E{(bf16_t*)(ws + WS_VT), MTOK};
          pg8::gemm_phase<EpiBf16>(F.lds, g, S, E); }
        SEAM(PH_P1);
    }

    if (IN(PH_P2)) {
        int tid_ = F.tid; asm volatile("" : "+v"(tid_));
        for (int it = F.vcu * 2; it < MTOK / 16; it += F.G * 2) {
            p2_conv_item((const bf16_t*)(ws + WS_HGLU), F.in[I_DWW], F.in[I_DWB], F.in[I_CLNG], F.in[I_CLNB], (bf16_t*)(ws + WS_HC), it * 16, (LAS float*)F.lds, tid_);
            p2_conv_item((const bf16_t*)(ws + WS_HGLU), F.in[I_DWW], F.in[I_DWB], F.in[I_CLNG], F.in[I_CLNB], (bf16_t*)(ws + WS_HC), it * 16 + 16, (LAS float*)F.lds, tid_); }
        float lam;
        { float a = 0.f, c = 0.f; for (int i = 0; i < 64; ++i) { a += F.in[I_LQ1][i] * F.in[I_LK1][i]; c += F.in[I_LQ2][i] * F.in[I_LK2][i]; } lam = __expf(a) - __expf(c) + LAM_INIT; }
        for (int it = F.vcu; it < BATCH * AH * 8; it += F.G) { const int bh = it >> 3, s_ = it & 7;
            p2_attn_unit((const bf16_t*)(ws + WS_QB), (const bf16_t*)(ws + WS_KB), (const bf16_t*)(ws + WS_VT), (bf16_t*)(ws + WS_ON), F.in[I_SUBLN], lam, bh / AH, bh % AH, 15 - s_, F.lds, tid_);
            p2_attn_unit((const bf16_t*)(ws + WS_QB), (const bf16_t*)(ws + WS_KB), (const bf16_t*)(ws + WS_VT), (bf16_t*)(ws + WS_ON), F.in[I_SUBLN], lam, bh / AH, bh % AH, s_, F.lds, tid_); }
        SEAM(PH_P2);
    }
    if (IN(PH_P3)) {
        pg8::StaticOrder S; S.init(MTOK, DM, F.G, (int)blockIdx.x);
        { pg8::Gemm g{(const bf16_t*)(ws + WS_HC), (const bf16_t*)(ws + WS_WCT), 1024, 1024, 1024};
          EpiF32<0> E{(float*)(ws + WS_T1), (const bf16_t*)(ws + WS_GT), nullptr, nullptr, nullptr, nullptr}; pg8::gemm_phase<EpiF32<0>>(F.lds, g, S, E); }
        { pg8::Gemm g{(const bf16_t*)(ws + WS_ON), (const bf16_t*)(ws + WS_WOT), 1024, 1024, 1024};
          EpiF32<1> E{(float*)(ws + WS_T1), (const bf16_t*)(ws + WS_GT), (bf16_t*)(ws + WS_MIXED), nullptr, nullptr, nullptr}; pg8::gemm_phase<EpiF32<1>>(F.lds, g, S, E); }
        SEAM(PH_P3);
    }
    if (IN(PH_P4)) {
        pg8::StaticOrder S; S.init(MTOK, DM, F.G, (int)blockIdx.x);
        pg8::Gemm g{(const bf16_t*)(ws + WS_MIXED), (const bf16_t*)(ws + WS_WOUTT), DM, DM, DM};
        EpiF32<2> E{nullptr, nullptr, nullptr, F.in[I_X], (float*)(ws + WS_X1F), nullptr}; pg8::gemm_phase<EpiF32<2>>(F.lds, g, S, E);
        SEAM(PH_P4);
    }
    if (IN(PH_P5)) {
        const int gw = F.vcu * NWAVES + F.wave, NGW = F.G * NWAVES;
        for (int m = gw; m < MTOK; m += NGW) ln_row_2048((const float*)(ws + WS_X1F) + (size_t)m * DM, F.in[I_LN1G], F.in[I_LN1B], (float*)(ws + WS_X1F) + (size_t)m * DM, (bf16_t*)(ws + WS_X1B) + (size_t)m * DM, F.lane);
        SEAM(PH_P5);
    }
    if (IN(PH_P6)) {
        pg8::StaticOrder S; S.init(MTOK, DM, F.G, (int)blockIdx.x);
        pg8::Gemm g{(const bf16_t*)(ws + WS_X1B), (const bf16_t*)(ws + WS_WQT), DM, DM, DM};
        EpiBf16 E{(bf16_t*)(ws + WS_QP), DM}; pg8::gemm_phase<EpiBf16>(F.lds, g, S, E);
        SEAM(PH_P6);
    }
    if (IN(PH_P7)) {
        int lane_ = F.lane; asm volatile("" : "+v"(lane_));
        const int per = MTOK / F.G;
        for (int t0 = 0; t0 < per; t0 += 32)
            p7_tile((const bf16_t*)(ws + WS_QP), (const bf16_t*)(ws + WS_SK), (int*)(ws + WS_IDS), (float*)(ws + WS_GW), F.vcu * per + t0, F.wave, (LAS int*)(F.lds + F.wave * 8192), lane_);
        SEAM(PH_P7);
    }
    if (IN(PH_P8)) {
        int lane_ = F.lane; asm volatile("" : "+v"(lane_));
        const int per = MTOK / F.G;
        for (int k = F.wave; k < per; k += NWAVES) { const size_t m = (size_t)F.vcu * per + k;
            p8_token((const bf16_t*)(ws + WS_X1B) + m * DM, (const float*)(ws + WS_X1F) + m * DM, (const int*)(ws + WS_IDS) + m * 128, (const float*)(ws + WS_GW) + m * 128,
                     (const bf16_t*)(ws + WS_UB), (const bf16_t*)(ws + WS_VB), F.in[I_LN2G], F.in[I_LN2B], (float*)(ws + WS_X2F) + m * DM, (bf16_t*)(ws + WS_X2B) + m * DM, lane_); }
        SEAM(PH_P8);
    }
    if (IN(PH_P9)) {
        pg8::StaticOrder S; S.init(MTOK, DM, F.G, (int)blockIdx.x);
        { pg8::Gemm g{(const bf16_t*)(ws + WS_PB), (const bf16_t*)(ws + WS_WPT), P_DIM, P_DIM, P_DIM};
          EpiF32<3> E{(float*)(ws + WS_E), nullptr, nullptr, nullptr, nullptr, nullptr}; pg8::gemm_phase<EpiF32<3>>(F.lds, g, S, E); }
        { pg8::Gemm g{(const bf16_t*)(ws + WS_X2B), (const bf16_t*)(ws + WS_WPGT), DM, DM, DM};
          EpiF32<4> E{(float*)(ws + WS_E), nullptr, nullptr, (const float*)(ws + WS_X2F), F.out, F.in[I_PLEBG]}; pg8::gemm_phase<EpiF32<4>>(F.lds, g, S, E); }
    }
#undef IN
#undef SEAM
}
extern "C" void kernel_launch(void* const* d_in, const int* in_sizes, int n_in, void* d_out, int out_size, void* d_ws, size_t ws_size, hipStream_t stream) {
    static int grid = 0;
    if (grid == 0) {
        if (n_in != N_IN || ws_size < WS_END) { fprintf(stderr, "kernel_launch: unexpected n_in %d / ws_size %zu\n", n_in, ws_size); grid = -1; return; }
        int dev = 0, cus = 0;
        if (hipGetDevice(&dev) != hipSuccess || hipDeviceGetAttribute(&cus, hipDeviceAttributeMultiprocessorCount, dev) != hipSuccess) { grid = -1; return; }
        if (hipFuncSetAttribute((const void*)mk_fwd, hipFuncAttributeMaxDynamicSharedMemorySize, LDS_BYTES) != hipSuccess) { fprintf(stderr, "kernel_launch: hipFuncSetAttribute failed\n"); grid = -1; return; }
        (void)hipGetLastError();
        grid = cus;
    }
    if (grid < 0) return;
    (void)hipMemsetAsync((unsigned char*)d_ws + WS_CTL, 0, CTL_ZERO_BYTES, stream);
    Args a{}; for (int i = 0; i < N_IN; ++i) a.in[i] = (const float*)d_in[i]; a.out = (float*)d_out; a.ws = (unsigned char*)d_ws;
    a.ph_lo = 0; a.ph_hi = PH_END;
    hipLaunchKernelGGL(mk_fwd, dim3(grid), dim3(NTHREADS), LDS_BYTES, stream, a);
}
```

```cpp
#include <hip/hip_runtime.h>
#include <cstdio>
#include <cstdint>
#include <cmath>

constexpr int DM = 2048, BATCH = 4, SEQ = 2048, MTOK = BATCH * SEQ;
constexpr int P_DIM = 256, CONV_CH = 1024, CONV_W = 31, AH = 8, AHD = 64, AVD = 128;
constexpr int PH = 8, PNK = 128, PHALF = 128, PTOPK = 16, NEXP = PNK * PNK;
constexpr int COL_CONV = 2048, COL_Q = 1024, COL_K = 1024, COL_V = 1024, COL_GATE = 4096, IN_COLS = 9216;
constexpr int OFF_Q = 2048, OFF_K = 3072, OFF_V = 4096, OFF_G = 5120;
constexpr float LN_EPS = 1e-5f;
constexpr float ALPHA = 1.189207115002721f;
constexpr float LAM_INIT = 0.2f;
constexpr float LOG2E = 1.4426950408889634f;
constexpr float QSCALE = 0.125f * LOG2E;

typedef unsigned short bf16_t;
__device__ __forceinline__ unsigned f2bf(float f) { unsigned u = __builtin_bit_cast(unsigned, f); return (u + 0x7fffu + ((u >> 16) & 1u)) >> 16; }
__device__ __forceinline__ float bf2f(unsigned h) { return __builtin_bit_cast(float, h << 16); }
__device__ __forceinline__ float sigmoidf_(float v) { return 1.0f / (1.0f + __expf(-v)); }
__device__ __forceinline__ float gelu_tanh(float v) { const float u = 0.7978845608028654f * (v + 0.044715f * v * v * v); return 0.5f * v * (1.0f + tanhf(u)); }

constexpr size_t MiB = 1u << 20;
constexpr size_t WS_CTL = 0;
constexpr size_t WS_SK = 1 * MiB;
constexpr size_t WS_PB = 2 * MiB;
constexpr size_t WS_WCT = 6 * MiB, WS_WOT = 10 * MiB, WS_WOUTT = 14 * MiB, WS_WQT = 22 * MiB, WS_WPGT = 30 * MiB, WS_WPT = 38 * MiB;
constexpr size_t WS_UB = 40 * MiB, WS_VB = 72 * MiB;
constexpr size_t WS_USC = 104 * MiB, WS_VSC = 104 * MiB + 65536;
constexpr size_t WS_XB = 168 * MiB;
constexpr size_t WS_MIXED = WS_XB, WS_X1B = WS_XB;
constexpr size_t WS_WINT = 200 * MiB;
constexpr size_t WS_HC = 200 * MiB, WS_ON = 216 * MiB, WS_QP = 200 * MiB, WS_X2B = 200 * MiB;
constexpr size_t WS_HGLU = 236 * MiB, WS_QB = 252 * MiB, WS_KB = 268 * MiB, WS_VT = 284 * MiB;
constexpr size_t WS_T1 = 236 * MiB;
constexpr size_t WS_X2F = 236 * MiB;
constexpr size_t WS_GT = 300 * MiB;
constexpr size_t WS_X1F = 300 * MiB;
constexpr size_t WS_E = 364 * MiB;
constexpr size_t WS_IDS = 364 * MiB, WS_GW = 368 * MiB;
constexpr size_t WS_NT = 428 * MiB;
constexpr size_t WS_NTK = 492 * MiB;
constexpr size_t WS_END = 508 * MiB;

template <typename TA> __device__ __forceinline__ float ldA(const TA* p);
template <> __device__ __forceinline__ float ldA<float>(const float* p) { return *p; }
template <> __device__ __forceinline__ float ldA<bf16_t>(const bf16_t* p) { return bf2f(*p); }
template <typename TA>
__global__ void __launch_bounds__(256) ngemm(const TA* __restrict__ A, int lda, const float* __restrict__ B, int ldb, float* __restrict__ C, int ldc, int K) {
    __shared__ float As[16][65];
    __shared__ float Bs[16][65];
    const int tid = threadIdx.x, tx = tid & 15, ty = tid >> 4;
    const int m0 = blockIdx.y * 64, n0 = blockIdx.x * 64;
    float acc[4][4];
#pragma unroll
    for (int i = 0; i < 4; ++i)
#pragma unroll
        for (int j = 0; j < 4; ++j) acc[i][j] = 0.f;
    for (int k0 = 0; k0 < K; k0 += 16) {
#pragma unroll
        for (int i = 0; i < 4; ++i) { const int idx = tid + i * 256; const int r = idx >> 4, c = idx & 15; As[c][r] = ldA<TA>(A + (size_t)(m0 + r) * lda + k0 + c); }
#pragma unroll
        for (int i = 0; i < 4; ++i) { const int idx = tid + i * 256; const int r = idx >> 6, c = idx & 63; Bs[r][c] = B[(size_t)(k0 + r) * ldb + n0 + c]; }
        __syncthreads();
#pragma unroll
        for (int kk = 0; kk < 16; ++kk) {
            float a[4], b[4];
#pragma unroll
            for (int i = 0; i < 4; ++i) { a[i] = As[kk][ty * 4 + i]; b[i] = Bs[kk][tx * 4 + i]; }
#pragma unroll
            for (int i = 0; i < 4; ++i)
#pragma unroll
                for (int j = 0; j < 4; ++j) acc[i][j] = fmaf(a[i], b[j], acc[i][j]);
        }
        __syncthreads();
    }
#pragma unroll
    for (int i = 0; i < 4; ++i)
#pragma unroll
        for (int j = 0; j < 4; ++j) C[(size_t)(m0 + ty * 4 + i) * ldc + n0 + tx * 4 + j] = acc[i][j];
}

__global__ void n_cvt_bf16(const float* __restrict__ src, bf16_t* __restrict__ dst, size_t n) {
    for (size_t i = (size_t)blockIdx.x * blockDim.x + threadIdx.x; i < n; i += (size_t)gridDim.x * blockDim.x) dst[i] = (bf16_t)f2bf(src[i]);
}
__global__ void n_glu(const float* __restrict__ T, bf16_t* __restrict__ hglu) {
    for (size_t i = (size_t)blockIdx.x * blockDim.x + threadIdx.x; i < (size_t)MTOK * CONV_CH; i += (size_t)gridDim.x * blockDim.x) {
        const size_t m = i / CONV_CH, c = i % CONV_CH; hglu[i] = (bf16_t)f2bf(T[m * 2048 + c] * sigmoidf_(T[m * 2048 + 1024 + c])); }
}
__global__ void n_scale_bf16(const float* __restrict__ T, bf16_t* __restrict__ dst, float s, size_t n) {
    for (size_t i = (size_t)blockIdx.x * blockDim.x + threadIdx.x; i < n; i += (size_t)gridDim.x * blockDim.x) dst[i] = (bf16_t)f2bf(T[i] * s);
}
__global__ void n_vt(const float* __restrict__ T, bf16_t* __restrict__ VT) {
    for (size_t i = (size_t)blockIdx.x * blockDim.x + threadIdx.x; i < (size_t)MTOK * 1024; i += (size_t)gridDim.x * blockDim.x) {
        const size_t c = i / MTOK, m = i % MTOK; VT[i] = (bf16_t)f2bf(T[m * 1024 + c]); }
}
__global__ void n_gate(const float* __restrict__ T, const float* __restrict__ bg, bf16_t* __restrict__ Gt, int coff) {
    for (size_t i = (size_t)blockIdx.x * blockDim.x + threadIdx.x; i < (size_t)MTOK * 2048; i += (size_t)gridDim.x * blockDim.x) {
        const size_t m = i / 2048, c = i % 2048; Gt[m * 4096 + coff + c] = (bf16_t)f2bf(sigmoidf_(T[i] + bg[coff + c])); }
}
__global__ void n_dwconv(const bf16_t* __restrict__ hglu, const float* __restrict__ w, const float* __restrict__ b, float* __restrict__ T) {
    for (size_t i = (size_t)blockIdx.x * blockDim.x + threadIdx.x; i < (size_t)MTOK * CONV_CH; i += (size_t)gridDim.x * blockDim.x) {
        const int m = (int)(i / CONV_CH), c = (int)(i % CONV_CH), s = m % SEQ; float acc = b[c];
        for (int j = 0; j < CONV_W; ++j) { const int sp = s - (CONV_W - 1) + j; if (sp >= 0) acc = fmaf(bf2f(hglu[(size_t)(m - (CONV_W - 1) + j) * CONV_CH + c]), w[j * CONV_CH + c], acc); }
        T[i] = acc; }
}
__device__ __forceinline__ float block_sum_256(float v, float* red) {
#pragma unroll
    for (int o = 32; o > 0; o >>= 1) v += __shfl_xor(v, o);
    __syncthreads();
    if ((threadIdx.x & 63) == 0) red[threadIdx.x >> 6] = v;
    __syncthreads();
    return red[0] + red[1] + red[2] + red[3];
}
__global__ void __launch_bounds__(256) n_convln(const float* __restrict__ T, const float* __restrict__ g, const float* __restrict__ b, bf16_t* __restrict__ hc) {
    __shared__ float red[4];
    const int m = blockIdx.x, t = threadIdx.x; float v[4]; float s = 0.f;
#pragma unroll
    for (int i = 0; i < 4; ++i) { v[i] = T[(size_t)m * CONV_CH + t + 256 * i]; s += v[i]; }
    const float mean = block_sum_256(s, red) * (1.f / CONV_CH); float q = 0.f;
#pragma unroll
    for (int i = 0; i < 4; ++i) { v[i] -= mean; q += v[i] * v[i]; }
    const float rstd = rsqrtf(block_sum_256(q, red) * (1.f / CONV_CH) + LN_EPS);
#pragma unroll
    for (int i = 0; i < 4; ++i) { const int c = t + 256 * i; const float y = v[i] * rstd * g[c] + b[c]; hc[(size_t)m * CONV_CH + c] = (bf16_t)f2bf(y * sigmoidf_(y)); }
}
__global__ void n_subln(const float* __restrict__ T, const float* __restrict__ g, bf16_t* __restrict__ on) {
    const int i = blockIdx.x * blockDim.x + threadIdx.x; if (i >= MTOK * AH) return;
    const float* r = T + (size_t)i * 128; float ss = 0.f;
    for (int d = 0; d < 128; ++d) ss += r[d] * r[d];
    const float rs = rsqrtf(ss * (1.f / 128.f) + LN_EPS) * (1.f - LAM_INIT);
    for (int d = 0; d < 128; ++d) on[(size_t)i * 128 + d] = (bf16_t)f2bf(r[d] * rs * g[d]);
}
__global__ void n_mix(const float* __restrict__ T1, const float* __restrict__ T2, const bf16_t* __restrict__ Gt, bf16_t* __restrict__ mixed) {
    for (size_t i = (size_t)blockIdx.x * blockDim.x + threadIdx.x; i < (size_t)MTOK * DM; i += (size_t)gridDim.x * blockDim.x) {
        const size_t m = i / DM, c = i % DM; mixed[i] = (bf16_t)f2bf(bf2f(Gt[m * 4096 + c]) * T1[i] + bf2f(Gt[m * 4096 + 2048 + c]) * T2[i]); }
}
__global__ void __launch_bounds__(256) n_resln(const float* __restrict__ res, const float* __restrict__ add, const float* __restrict__ g, const float* __restrict__ b, float* __restrict__ yf, bf16_t* __restrict__ yb) {
    __shared__ float red[4];
    const int m = blockIdx.x, t = threadIdx.x; float v[8]; float s = 0.f;
#pragma unroll
    for (int i = 0; i < 8; ++i) { const size_t o = (size_t)m * DM + t + 256 * i; v[i] = ALPHA * res[o] + add[o]; s += v[i]; }
    const float mean = block_sum_256(s, red) * (1.f / DM); float q = 0.f;
#pragma unroll
    for (int i = 0; i < 8; ++i) { v[i] -= mean; q += v[i] * v[i]; }
    const float rstd = rsqrtf(block_sum_256(q, red) * (1.f / DM) + LN_EPS);
#pragma unroll
    for (int i = 0; i < 8; ++i) { const int c = t + 256 * i; const float y = v[i] * rstd * g[c] + b[c]; yf[(size_t)m * DM + c] = y; yb[(size_t)m * DM + c] = (bf16_t)f2bf(y); }
}
__global__ void n_scores(const bf16_t* __restrict__ qp, const float* __restrict__ sk, float* __restrict__ S) {
    for (size_t i = (size_t)blockIdx.x * blockDim.x + threadIdx.x; i < (size_t)MTOK * 2048; i += (size_t)gridDim.x * blockDim.x) {
        const size_t m = i / 2048; const int r = (int)(i % 2048), hc = r / 128, n = r % 128; float s = 0.f;
        for (int d = 0; d < 128; ++d) s = fmaf(bf2f(qp[m * 2048 + hc * 128 + d]), bf2f((unsigned)f2bf(sk[((size_t)hc * 128 + n) * 128 + d])), s);
        S[i] = s; }
}
__global__ void n_topk1(const float* __restrict__ S, float* __restrict__ vals, int* __restrict__ idx) {
    const int i = blockIdx.x * blockDim.x + threadIdx.x; if (i >= MTOK * 16) return;
    const float* s = S + (size_t)i * 128; float pv = INFINITY; int pi = -1;
    for (int r = 0; r < 16; ++r) { float bv = -INFINITY; int bi = 0x7fffffff;
        for (int n = 0; n < 128; ++n) { const float v = s[n]; const bool elig = (v < pv) || (v == pv && n > pi); if (elig && (v > bv || (v == bv && n < bi))) { bv = v; bi = n; } }
        vals[(size_t)i * 16 + r] = bv; idx[(size_t)i * 16 + r] = bi; pv = bv; pi = bi; }
}
__global__ void n_topk2(const float* __restrict__ vals, const int* __restrict__ idx, int* __restrict__ ids, float* __restrict__ gw) {
    const int i = blockIdx.x * blockDim.x + threadIdx.x; if (i >= MTOK * 8) return;
    const float* v0 = vals + (size_t)i * 32; const float* v1 = v0 + 16; const int* i0 = idx + (size_t)i * 32; const int* i1 = i0 + 16;
    float best[16]; float pv = INFINITY; int pf = -1;
#pragma unroll
    for (int r = 0; r < 16; ++r) { float bv = -INFINITY; int bf = 0x7fffffff;
        for (int f = 0; f < 256; ++f) { const float v = v0[f >> 4] + v1[f & 15]; const bool elig = (v < pv) || (v == pv && f > pf); if (elig && (v > bv || (v == bv && f < bf))) { bv = v; bf = f; } }
        best[r] = bv; ids[(size_t)i * 16 + r] = i0[bf >> 4] * PNK + i1[bf & 15]; pv = bv; pf = bf; }
    float sum = 0.f; const float bmax = best[0];
#pragma unroll
    for (int r = 0; r < 16; ++r) { best[r] = __expf(best[r] - bmax); sum += best[r]; }
    const float inv = 1.f / sum;
#pragma unroll
    for (int r = 0; r < 16; ++r) gw[(size_t)i * 16 + r] = best[r] * inv;
}
__global__ void __launch_bounds__(256) n_peer(const bf16_t* __restrict__ x1b, const float* __restrict__ x1f, const int* __restrict__ ids, const float* __restrict__ gw,
                                              const float* __restrict__ ut, const float* __restrict__ vt, const float* __restrict__ g, const float* __restrict__ b,
                                              float* __restrict__ x2f, bf16_t* __restrict__ x2b) {
    __shared__ float red[4]; __shared__ float wj[128];
    const int m = blockIdx.x, t = threadIdx.x; float xr[8];
#pragma unroll
    for (int i = 0; i < 8; ++i) xr[i] = bf2f(x1b[(size_t)m * DM + t + 256 * i]);
    for (int j = 0; j < 128; ++j) { const float* u = ut + (size_t)ids[(size_t)m * 128 + j] * DM; float s = 0.f;
#pragma unroll
        for (int i = 0; i < 8; ++i) s = fmaf(xr[i], u[t + 256 * i], s);
        const float hsum = block_sum_256(s, red);
        if (t == 0) wj[j] = gw[(size_t)m * 128 + j] * gelu_tanh(hsum); }
    __syncthreads();
    float o[8];
#pragma unroll
    for (int i = 0; i < 8; ++i) o[i] = 0.f;
    for (int j = 0; j < 128; ++j) { const float* v = vt + (size_t)ids[(size_t)m * 128 + j] * DM; const float w = wj[j];
#pragma unroll
        for (int i = 0; i < 8; ++i) o[i] = fmaf(w, v[t + 256 * i], o[i]); }
    float s = 0.f;
#pragma unroll
    for (int i = 0; i < 8; ++i) { o[i] += ALPHA * x1f[(size_t)m * DM + t + 256 * i]; s += o[i]; }
    const float mean = block_sum_256(s, red) * (1.f / DM); float q = 0.f;
#pragma unroll
    for (int i = 0; i < 8; ++i) { o[i] -= mean; q += o[i] * o[i]; }
    const float rstd = rsqrtf(block_sum_256(q, red) * (1.f / DM) + LN_EPS);
#pragma unroll
    for (int i = 0; i < 8; ++i) { const int c = t + 256 * i; const float y = o[i] * rstd * g[c] + b[c]; x2f[(size_t)m * DM + c] = y; x2b[(size_t)m * DM + c] = (bf16_t)f2bf(y); }
}
__global__ void n_final(const float* __restrict__ x2f, const float* __restrict__ T, const float* __restrict__ bg, const float* __restrict__ E, float* __restrict__ out) {
    for (size_t i = (size_t)blockIdx.x * blockDim.x + threadIdx.x; i < (size_t)MTOK * DM; i += (size_t)gridDim.x * blockDim.x) {
        const size_t c = i % DM; out[i] = x2f[i] + sigmoidf_(T[i] + bg[c]) * E[i]; }
}
__global__ void n_lambda(const float* q1, const float* k1, const float* q2, const float* k2, float* lam) {
    if (threadIdx.x == 0 && blockIdx.x == 0) { float a = 0.f, b = 0.f; for (int i = 0; i < 64; ++i) { a += q1[i] * k1[i]; b += q2[i] * k2[i]; } lam[0] = expf(a) - expf(b) + LAM_INIT; }
}

enum { I_X = 0, I_P, I_WIN, I_BGATE, I_DWW, I_DWB, I_CLNG, I_CLNB, I_CWOUT, I_LQ1, I_LK1, I_LQ2, I_LK2, I_SUBLN, I_AWO, I_WOUT, I_LN1G, I_LN1B, I_PWQ, I_PSK, I_PU, I_PV, I_LN2G, I_LN2B, I_PLEWP, I_PLEWG, I_PLEBG, N_IN };
__global__ void __launch_bounds__(64) n_attn2(const bf16_t* __restrict__ Qb, const bf16_t* __restrict__ Kb, const bf16_t* __restrict__ VT, const float* __restrict__ lamp, float* __restrict__ T) {
    const float lam = lamp[0];
    const int q = blockIdx.x * 64 + threadIdx.x, chunk = blockIdx.y, bh = blockIdx.z, b = bh / AH, h = bh % AH;
    const float slope2 = exp2f(-(float)(h + 1)) * LOG2E;
    const size_t rowq = (size_t)b * SEQ + q;
    float res[32];
#pragma unroll
    for (int d = 0; d < 32; ++d) res[d] = 0.f;
    const int kmax = blockIdx.x * 64 + 63;
    for (int map = 0; map < 2; ++map) {
        float qv[64];
#pragma unroll
        for (int d = 0; d < 64; ++d) qv[d] = bf2f(Qb[rowq * 1024 + h * 128 + map * 64 + d]);
        float o[32];
#pragma unroll
        for (int d = 0; d < 32; ++d) o[d] = 0.f;
        float mx = -INFINITY, l = 0.f;
        for (int k = 0; k <= kmax; ++k) {
            const bf16_t* kr = Kb + ((size_t)b * SEQ + k) * 1024 + h * 128 + map * 64; float s = 0.f;
#pragma unroll
            for (int d = 0; d < 64; ++d) s = fmaf(qv[d], bf2f(kr[d]), s);
            s -= slope2 * (float)(q - k);
            if (k <= q) {
                const float mn = fmaxf(mx, s), c = exp2f(mx - mn), p = exp2f(s - mn); l = l * c + p; mx = mn;
#pragma unroll
                for (int d = 0; d < 32; ++d) o[d] = o[d] * c + p * bf2f(VT[(size_t)(h * 128 + chunk * 32 + d) * MTOK + (size_t)b * SEQ + k]);
            }
        }
        const float il = 1.f / l, sg = map == 0 ? 1.f : -lam;
#pragma unroll
        for (int d = 0; d < 32; ++d) res[d] += sg * o[d] * il;
    }
#pragma unroll
    for (int d = 0; d < 32; ++d) T[rowq * 1024 + h * 128 + chunk * 32 + d] = res[d];
}

#define GAS __attribute__((address_space(1)))
#define LAS __attribute__((address_space(3)))
typedef short bf16x8 __attribute__((ext_vector_type(8)));
typedef float f32x4 __attribute__((ext_vector_type(4)));
typedef float f32x2 __attribute__((ext_vector_type(2)));
typedef float f32x16 __attribute__((ext_vector_type(16)));
typedef unsigned u32x4 __attribute__((ext_vector_type(4)));
typedef unsigned u32x2 __attribute__((ext_vector_type(2)));
typedef __bf16 bf16x2_t __attribute__((ext_vector_type(2)));
typedef GAS unsigned gu32;
#define RLX_AGENT __ATOMIC_RELAXED, __HIP_MEMORY_SCOPE_AGENT
#define LDS_WAIT() asm volatile("s_waitcnt lgkmcnt(0)" ::: "memory")
#define VM_WAIT() asm volatile("s_waitcnt vmcnt(0)" ::: "memory")
constexpr int NWAVES = 8, NTHREADS = 512;
constexpr int RING_BYTES = 131072;
constexpr int XTRA_OFF = RING_BYTES;
constexpr int MISC_OFF = 161792;
constexpr int LDS_BYTES = 163840;

__device__ __forceinline__ unsigned pk2(float lo, float hi) { f32x2 v = {lo, hi}; bf16x2_t b = __builtin_convertvector(v, bf16x2_t); return __builtin_bit_cast(unsigned, b); }
__device__ __forceinline__ float bflo(unsigned w) { return __builtin_bit_cast(float, w << 16); }
__device__ __forceinline__ float bfhi(unsigned w) { return __builtin_bit_cast(float, w & 0xffff0000u); }
__device__ __forceinline__ float fsigmoid(float v) { return __builtin_amdgcn_rcpf(1.0f + __builtin_amdgcn_exp2f(-LOG2E * v)); }

#define XB_TMO      128
#define XB_XCNT(j)  (256  + 64 * (j))
#define XB_XSUB(j)  (1280 + 64 * (j))
#define XB_XGEN(j)  (2304 + 64 * (j))
#define XB_TOP      3328
#define XB_TOPGEN   3392
#define XCD_BAR_WORDS 3456
#define XB_SPIN_CAP (1u << 22)
__device__ __forceinline__ unsigned xb_ld(unsigned* p)              { return __hip_atomic_load(p, __ATOMIC_RELAXED, __HIP_MEMORY_SCOPE_AGENT); }
__device__ __forceinline__ unsigned xb_add(unsigned* p, unsigned v) { return __hip_atomic_fetch_add(p, v, __ATOMIC_RELAXED, __HIP_MEMORY_SCOPE_AGENT); }
__device__ __forceinline__ unsigned xb_xcc_id() { return (unsigned)__builtin_amdgcn_s_getreg((3 << 11) | 20) & 0xFu; }
#define XB_SPIN(cond, bar) do { unsigned _sp = 0; while (cond) { __builtin_amdgcn_s_sleep(1); \
    if ((++_sp & 255u) == 0u) { if (xb_ld(&(bar)[XB_TMO])) break; if (_sp > XB_SPIN_CAP) { atomicAdd(&(bar)[XB_TMO], 1u); break; } } } } while (0)
struct XcdBarrier { unsigned* bar; unsigned x; volatile LAS unsigned* st; };
__device__ __forceinline__ XcdBarrier xcd_barrier_post(unsigned* bar, volatile LAS unsigned* st) {
    XcdBarrier b; b.bar = bar; b.x = xb_xcc_id(); b.st = st;
    if (threadIdx.x == 0) (void)xb_add(&bar[XB_XCNT(b.x)], 1u);
    return b;
}
__device__ __forceinline__ void xcd_barrier_complete(unsigned* bar, unsigned x, unsigned& nloc, unsigned& nx) {
    const unsigned G = gridDim.x * gridDim.y * gridDim.z;
    unsigned sum, cnt, mine, sp = 0u;
    for (;;) {
        sum = 0u; cnt = 0u; mine = 0u;
#pragma unroll
        for (unsigned j = 0; j < 16; ++j) { const unsigned c = xb_ld(&bar[XB_XCNT(j)]); sum += c; cnt += (c > 0u) ? 1u : 0u; mine = (j == x) ? c : mine; }
        if (sum == G) break;
        __builtin_amdgcn_s_sleep(1);
        if ((++sp & 255u) == 0u) { if (xb_ld(&bar[XB_TMO])) break; if (sp > XB_SPIN_CAP) { atomicAdd(&bar[XB_TMO], 1u); break; } }
    }
    nloc = mine > 0u ? mine : 1u; nx = cnt > 0u ? cnt : 1u;
}
__device__ __forceinline__ void xcd_barrier(const XcdBarrier& b) {
    asm volatile("s_waitcnt vmcnt(0)" ::: "memory");
    __syncthreads();
    if (threadIdx.x == 0) {
        unsigned* bar = b.bar;
        __builtin_amdgcn_s_waitcnt(0);
        unsigned nloc = b.st[0], nx = b.st[1];
        if (nloc == 0u) { xcd_barrier_complete(bar, b.x, nloc, nx); b.st[0] = nloc; b.st[1] = nx; }
        const unsigned old = xb_add(&bar[XB_XSUB(b.x)], 1u);
        const unsigned gen = old / nloc;
        if (old + 1u == (gen + 1u) * nloc) {
            __builtin_amdgcn_fence(__ATOMIC_RELEASE, "agent");
            asm volatile("s_waitcnt vmcnt(0)" ::: "memory");
            const unsigned og = xb_add(&bar[XB_TOP], 1u);
            const unsigned tg = og / nx;
            if (og + 1u == (tg + 1u) * nx) xb_add(&bar[XB_TOPGEN], 1u);
            else XB_SPIN(xb_ld(&bar[XB_TOPGEN]) == tg, bar);
            __builtin_amdgcn_fence(__ATOMIC_ACQUIRE, "agent");
            xb_add(&bar[XB_XGEN(b.x)], 1u);
            asm volatile("s_waitcnt vmcnt(0)" ::: "memory");
        } else {
            XB_SPIN(xb_ld(&bar[XB_XGEN(b.x)]) == gen, bar);
            __builtin_amdgcn_fence(__ATOMIC_ACQUIRE, "agent");
            asm volatile("s_waitcnt vmcnt(0)" ::: "memory");
        }
    }
    __syncthreads();
}

namespace pg8 {
constexpr int BM = 256, BK = 64, HALF = 128, HTB = HALF * BK * 2, STAGE_BYTES = 8 * HTB, NXCD = 8, WGM = 8;
__host__ __device__ __forceinline__ int lds_byte(int r, int c) { const int st = (r >> 4) * 2 + (c >> 5), rr = r & 15, cc = c & 31, ob = rr * 64 + cc * 2; return st * 1024 + (ob ^ (((ob >> 9) & 1) << 5)); }
__host__ __device__ __forceinline__ void stage_rc(int b, int& R, int& C) { const int st = b / 1024, sb = b % 1024, swz = sb ^ (((sb >> 9) & 1) << 5); R = (st >> 1) * 16 + swz / 64; C = (st & 1) * 32 + (swz % 64) / 2; }
__host__ __device__ __forceinline__ int perm32(int rho) { const int n = rho >> 4, i = rho & 15; return 8 * (i >> 2) + 4 * n + (i & 3); }
struct Unit { int pm, pn; };
struct Gemm { const bf16_t* A; const bf16_t* Bt; int lda, ldb, K; };
struct StaticOrder {
    int nM, nN, nwg, G, c;
    __host__ __device__ void init(int M, int N, int G_, int c_) { nM = M / BM; nN = N / BM; nwg = nM * nN; G = G_; c = c_; }
    __host__ __device__ bool next(int i, Unit& u) const {
        const long L = (long)i * G + c; if (L >= nwg) return false;
        int wgid = (int)L; { const int q = nwg / NXCD, r = nwg % NXCD, xcd = wgid % NXCD, off = wgid / NXCD; wgid = (xcd < r ? xcd * (q + 1) : r * (q + 1) + (xcd - r) * q) + off; }
        const int nig = WGM * nN, gid = wgid / nig, fm = gid * WGM, gsz = (nM - fm) < WGM ? (nM - fm) : WGM;
        u.pm = fm + ((wgid % nig) % gsz); u.pn = (wgid % nig) / gsz; return true;
    }
};
template <class Epi, bool SP2 = true>
__device__ __forceinline__ void gemm_phase(LAS unsigned char* lds, const Gemm g, const StaticOrder& S, const Epi& E) {
    int tid_ = threadIdx.x; asm volatile("" : "+v"(tid_));
    const int tid = tid_, wid = __builtin_amdgcn_readfirstlane(tid >> 6), lane = tid & 63, wr = wid >> 2, wc = wid & 3, fr = lane & 15, fq = lane >> 4;
    const int K = g.K, nt = K / BK;
    unsigned voffA[2], voffB[2];
#pragma unroll
    for (int i = 0; i < 2; ++i) { int R, C; stage_rc(tid * 16 + i * 8192, R, C); const int Rb = Epi::PERM ? ((R & ~31) + perm32(R & 31)) : R;
        voffA[i] = (unsigned)(R * g.lda + C) * 2u; voffB[i] = (unsigned)(Rb * g.ldb + C) * 2u; }
    const size_t kstep = (size_t)(BK * 2);
    const size_t hstepA = (size_t)HALF * g.lda * 2, hstepB = (size_t)HALF * g.ldb * 2;
    const size_t tstepA = 2 * hstepA, tstepB = 2 * hstepB;
    const unsigned ldsw = (unsigned)wid * 1024u;
    const int aoff = lds_byte(wr * 64 + fr, fq * 8), boff = lds_byte(wc * 32 + fr, fq * 8);
#define PG8_SA(b, h) (((b) * 2 + (h)) * HTB)
#define PG8_SB(b, h) ((4 + (b) * 2 + (h)) * HTB)
#define PG8_STAGE(bufoff, gbase, voff) do { _Pragma("unroll") for (int _i = 0; _i < 2; ++_i) \
        __builtin_amdgcn_global_load_lds((const unsigned*)((const char*)(gbase) + (voff)[_i]), (LAS unsigned*)(lds + (bufoff) + ldsw + _i * 8192), 16, 0, 0); } while (0)
#define PG8_LDA(dst, b, h) do { _Pragma("unroll") for (int m = 0; m < 4; ++m) _Pragma("unroll") for (int k = 0; k < 2; ++k) dst[m][k] = *(const LAS bf16x8*)(lds + PG8_SA(b, h) + aoff + m * 2048 + k * 1024); } while (0)
#define PG8_LDB(dst, b, h) do { _Pragma("unroll") for (int n = 0; n < 2; ++n) _Pragma("unroll") for (int k = 0; k < 2; ++k) dst[n][k] = *(const LAS bf16x8*)(lds + PG8_SB(b, h) + boff + n * 2048 + k * 1024); } while (0)
#define PG8_MMA(ai, bj, At, Bt) do { __builtin_amdgcn_s_setprio(1); _Pragma("unroll") for (int m = 0; m < 4; ++m) _Pragma("unroll") for (int n = 0; n < 2; ++n) _Pragma("unroll") for (int k = 0; k < 2; ++k) \
        acc[ai][bj][m][n] = __builtin_amdgcn_mfma_f32_16x16x32_bf16(Bt[n][k], At[m][k], acc[ai][bj][m][n], 0, 0, 0); __builtin_amdgcn_s_setprio(0); } while (0)
#define PG8_WAIT_V(n) asm volatile("s_waitcnt vmcnt(" #n ")" ::: "memory")
#define PG8_WAIT_L(n) asm volatile("s_waitcnt lgkmcnt(" #n ")" ::: "memory")
#define PG8_BAR __builtin_amdgcn_s_barrier()
#define PG8_SCHED __builtin_amdgcn_sched_barrier(0)
    Unit cur, nxt; int ui = 0;
    if (!S.next(0, cur)) return;
    f32x4 acc[2][2][4][2];
#pragma unroll
    for (int a = 0; a < 2; ++a)
#pragma unroll
        for (int b = 0; b < 2; ++b)
#pragma unroll
            for (int m = 0; m < 4; ++m)
#pragma unroll
                for (int n = 0; n < 2; ++n) acc[a][b][m][n] = (f32x4){0.f, 0.f, 0.f, 0.f};
    bf16x8 At[4][2], B0[2][2], B1[2][2];
    const char* cA = (const char*)g.A + (size_t)cur.pm * tstepA; const char* cB = (const char*)g.Bt + (size_t)cur.pn * tstepB;
    if constexpr (SP2) {
        PG8_STAGE(PG8_SB(0, 0), cB, voffB); PG8_STAGE(PG8_SB(0, 1), cB + hstepB, voffB); PG8_STAGE(PG8_SA(0, 0), cA, voffA); PG8_STAGE(PG8_SA(0, 1), cA + hstepA, voffA);
        if (wr == 1) PG8_BAR;
        PG8_WAIT_V(2); PG8_BAR;
        PG8_STAGE(PG8_SB(1, 0), cB + kstep, voffB); PG8_STAGE(PG8_SA(1, 0), cA + kstep, voffA); PG8_STAGE(PG8_SB(1, 1), cB + hstepB + kstep, voffB);
        PG8_WAIT_V(6); PG8_BAR;
    } else {
        PG8_STAGE(PG8_SB(0, 0), cB, voffB); PG8_STAGE(PG8_SA(0, 0), cA, voffA); PG8_STAGE(PG8_SB(0, 1), cB + hstepB, voffB); PG8_STAGE(PG8_SA(0, 1), cA + hstepA, voffA);
        if (wr == 1) PG8_BAR;
        PG8_WAIT_V(4); PG8_BAR;
        PG8_STAGE(PG8_SB(1, 0), cB + kstep, voffB); PG8_STAGE(PG8_SA(1, 0), cA + kstep, voffA); PG8_STAGE(PG8_SB(1, 1), cB + hstepB + kstep, voffB);
        PG8_WAIT_V(6); PG8_BAR;
    }
    for (;;) {
        const bool has_next = S.next(ui + 1, nxt);
        const char* nA = has_next ? (const char*)g.A + (size_t)nxt.pm * tstepA : cA; const char* nB = has_next ? (const char*)g.Bt + (size_t)nxt.pn * tstepB : cB;
        for (int t = 0; t < nt; t += 2) {
            const bool last = (t == nt - 2);
            const char* a1 = cA + (size_t)(t + 1) * kstep;
            const char* a2 = last ? nA : cA + (size_t)(t + 2) * kstep; const char* b2 = last ? nB : cB + (size_t)(t + 2) * kstep;
            const char* a3 = a2 + kstep; const char* b3 = b2 + kstep;
            if constexpr (SP2) {
            PG8_LDB(B0, 0, 0); PG8_LDB(B1, 0, 1); PG8_SCHED; PG8_LDA(At, 0, 0); PG8_STAGE(PG8_SA(1, 1), a1 + hstepA, voffA);
            PG8_WAIT_V(8); PG8_WAIT_L(0); PG8_BAR; PG8_MMA(0, 0, At, B0); PG8_MMA(0, 1, At, B1); PG8_BAR; PG8_SCHED;
            PG8_LDA(At, 0, 1); PG8_STAGE(PG8_SB(0, 0), b2, voffB); PG8_STAGE(PG8_SB(0, 1), b2 + hstepB, voffB); PG8_STAGE(PG8_SA(0, 0), a2, voffA);
            PG8_WAIT_V(8); PG8_WAIT_L(0); PG8_BAR; PG8_MMA(1, 0, At, B0); PG8_MMA(1, 1, At, B1); PG8_BAR; PG8_SCHED;
            PG8_LDB(B0, 1, 0); PG8_LDB(B1, 1, 1); PG8_SCHED; PG8_LDA(At, 1, 0); PG8_STAGE(PG8_SA(0, 1), a2 + hstepA, voffA);
            PG8_WAIT_V(8); PG8_WAIT_L(0); PG8_BAR; PG8_MMA(0, 0, At, B0); PG8_MMA(0, 1, At, B1); PG8_BAR; PG8_SCHED;
            PG8_LDA(At, 1, 1); PG8_STAGE(PG8_SB(1, 0), b3, voffB); PG8_STAGE(PG8_SB(1, 1), b3 + hstepB, voffB); PG8_STAGE(PG8_SA(1, 0), a3, voffA);
            PG8_WAIT_V(8); PG8_WAIT_L(0); PG8_BAR; PG8_MMA(1, 0, At, B0); PG8_MMA(1, 1, At, B1); PG8_BAR; PG8_SCHED;
            } else {
            PG8_LDB(B0, 0, 0); PG8_SCHED; PG8_LDA(At, 0, 0); PG8_STAGE(PG8_SA(1, 1), a1 + hstepA, voffA);
            PG8_WAIT_L(8); PG8_BAR; PG8_WAIT_L(0); PG8_MMA(0, 0, At, B0); PG8_BAR; PG8_SCHED;
            PG8_LDB(B1, 0, 1); PG8_STAGE(PG8_SB(0, 0), b2, voffB);
            PG8_BAR; PG8_WAIT_L(0); PG8_MMA(0, 1, At, B1); PG8_BAR;
            PG8_LDA(At, 0, 1); PG8_STAGE(PG8_SA(0, 0), a2, voffA);
            PG8_BAR; PG8_WAIT_L(0); PG8_MMA(1, 0, At, B0); PG8_BAR; PG8_SCHED;
            PG8_STAGE(PG8_SB(0, 1), b2 + hstepB, voffB);
            PG8_WAIT_V(6); PG8_BAR; PG8_MMA(1, 1, At, B1); PG8_BAR;
            PG8_LDB(B0, 1, 0); PG8_SCHED; PG8_LDA(At, 1, 0); PG8_STAGE(PG8_SA(0, 1), a2 + hstepA, voffA);
            PG8_WAIT_L(8); PG8_BAR; PG8_WAIT_L(0); PG8_MMA(0, 0, At, B0); PG8_BAR; PG8_SCHED;
            PG8_LDB(B1, 1, 1); PG8_STAGE(PG8_SB(1, 0), b3, voffB);
            PG8_BAR; PG8_WAIT_L(0); PG8_MMA(0, 1, At, B1); PG8_BAR;
            PG8_LDA(At, 1, 1); PG8_STAGE(PG8_SA(1, 0), a3, voffA);
            PG8_BAR; PG8_WAIT_L(0); PG8_MMA(1, 0, At, B0); PG8_BAR; PG8_SCHED;
            PG8_STAGE(PG8_SB(1, 1), b3 + hstepB, voffB);
            PG8_WAIT_V(6); PG8_BAR; PG8_MMA(1, 1, At, B1); PG8_BAR;
            }
        }
        if (wr == 0) PG8_BAR;
        E(acc, cur, wr, wc, fr, fq);
        if (!has_next) break;
#pragma unroll
        for (int a = 0; a < 2; ++a)
#pragma unroll
            for (int b = 0; b < 2; ++b)
#pragma unroll
                for (int m = 0; m < 4; ++m)
#pragma unroll
                    for (int n = 0; n < 2; ++n) acc[a][b][m][n] = (f32x4){0.f, 0.f, 0.f, 0.f};
        cur = nxt; cA = nA; cB = nB; ++ui;
        if (wr == 1) PG8_BAR;
    }
    PG8_WAIT_V(0);
    PG8_BAR;
#undef PG8_SA
#undef PG8_SB
#undef PG8_STAGE
#undef PG8_LDA
#undef PG8_LDB
#undef PG8_MMA
#undef PG8_WAIT_V
#undef PG8_WAIT_L
#undef PG8_BAR
#undef PG8_SCHED
}
}

typedef f32x4 Acc[2][2][4][2];
struct EpiP1 {
    static constexpr bool PERM = true;
    bf16_t *hglu, *Qb, *Kb, *Gt; const float* bgate;
    __device__ __forceinline__ void operator()(const Acc& acc, const pg8::Unit& u, int wr, int wc, int fr, int fq) const {
        const int row0 = u.pm * 256 + wr * 64 + fr, pn = u.pn;
        if (pn < 8) {
            const int col0 = pn * 128 + wc * 32 + 8 * fq;
#pragma unroll
            for (int ai = 0; ai < 2; ++ai)
#pragma unroll
                for (int m = 0; m < 4; ++m) { const f32x4 a0 = acc[ai][0][m][0], a1 = acc[ai][0][m][1], g0 = acc[ai][1][m][0], g1 = acc[ai][1][m][1]; u32x4 w;
                    w.x = pk2(a0[0] * fsigmoid(g0[0]), a0[1] * fsigmoid(g0[1])); w.y = pk2(a0[2] * fsigmoid(g0[2]), a0[3] * fsigmoid(g0[3]));
                    w.z = pk2(a1[0] * fsigmoid(g1[0]), a1[1] * fsigmoid(g1[1])); w.w = pk2(a1[2] * fsigmoid(g1[2]), a1[3] * fsigmoid(g1[3]));
                    *(u32x4*)(hglu + (size_t)(row0 + ai * 128 + m * 16) * CONV_CH + col0) = w; }
        } else if (pn < 16) {
            bf16_t* dst = pn < 12 ? Qb : Kb; const float sc = pn < 12 ? QSCALE : 1.0f; const int col0 = (pn & 3) * 256 + wc * 32 + 8 * fq;
#pragma unroll
            for (int ai = 0; ai < 2; ++ai)
#pragma unroll
                for (int m = 0; m < 4; ++m)
#pragma unroll
                    for (int bj = 0; bj < 2; ++bj) { const f32x4 v0 = acc[ai][bj][m][0] * sc, v1 = acc[ai][bj][m][1] * sc; u32x4 w;
                        w.x = pk2(v0[0], v0[1]); w.y = pk2(v0[2], v0[3]); w.z = pk2(v1[0], v1[1]); w.w = pk2(v1[2], v1[3]);
                        *(u32x4*)(dst + (size_t)(row0 + ai * 128 + m * 16) * 1024 + col0 + bj * 128) = w; }
        } else {
            const int col0 = (pn - 16) * 256 + wc * 32 + 8 * fq;
#pragma unroll
            for (int bj = 0; bj < 2; ++bj) { const f32x4 b0 = *(const f32x4*)(bgate + col0 + bj * 128), b1 = *(const f32x4*)(bgate + col0 + bj * 128 + 4);
#pragma unroll
                for (int ai = 0; ai < 2; ++ai)
#pragma unroll
                    for (int m = 0; m < 4; ++m) { const f32x4 v0 = acc[ai][bj][m][0] + b0, v1 = acc[ai][bj][m][1] + b1; u32x4 w;
                        w.x = pk2(fsigmoid(v0[0]), fsigmoid(v0[1])); w.y = pk2(fsigmoid(v0[2]), fsigmoid(v0[3])); w.z = pk2(fsigmoid(v1[0]), fsigmoid(v1[1])); w.w = pk2(fsigmoid(v1[2]), fsigmoid(v1[3]));
                        *(u32x4*)(Gt + (size_t)(row0 + ai * 128 + m * 16) * 4096 + col0 + bj * 128) = w; } }
        }
    }
};
struct EpiBf16 {
    static constexpr bool PERM = true;
    bf16_t* O; int ldc;
    __device__ __forceinline__ void operator()(const Acc& acc, const pg8::Unit& u, int wr, int wc, int fr, int fq) const {
        const int row0 = u.pm * 256 + wr * 64 + fr, col0 = u.pn * 256 + wc * 32 + 8 * fq;
#pragma unroll
        for (int ai = 0; ai < 2; ++ai)
#pragma unroll
            for (int m = 0; m < 4; ++m)
#pragma unroll
                for (int bj = 0; bj < 2; ++bj) { const f32x4 v0 = acc[ai][bj][m][0], v1 = acc[ai][bj][m][1]; u32x4 w;
                    w.x = pk2(v0[0], v0[1]); w.y = pk2(v0[2], v0[3]); w.z = pk2(v1[0], v1[1]); w.w = pk2(v1[2], v1[3]);
                    *(u32x4*)(O + (size_t)(row0 + ai * 128 + m * 16) * ldc + col0 + bj * 128) = w; }
    }
};
template <int MODE> struct EpiF32 {
    static constexpr bool PERM = false;
    float* T1; const bf16_t* G; bf16_t* OB; const float* X; float* OUT; const float* bias;
    __device__ __forceinline__ void operator()(const Acc& acc, const pg8::Unit& u, int wr, int wc, int fr, int fq) const {
        const int row0 = u.pm * 256 + wr * 64 + fr, col0 = u.pn * 256 + wc * 32 + 4 * fq;
#pragma unroll
        for (int ai = 0; ai < 2; ++ai)
#pragma unroll
            for (int m = 0; m < 4; ++m) { const size_t row = (size_t)(row0 + ai * 128 + m * 16);
#pragma unroll
                for (int bj = 0; bj < 2; ++bj)
#pragma unroll
                    for (int n = 0; n < 2; ++n) { const int col = col0 + bj * 128 + n * 16; const f32x4 a = acc[ai][bj][m][n]; const size_t o = row * DM + col;
                        if constexpr (MODE == 0) { const u32x2 gw_ = *(const u32x2*)(G + row * 4096 + col); *(f32x4*)(T1 + o) = (f32x4){a[0] * bflo(gw_.x), a[1] * bfhi(gw_.x), a[2] * bflo(gw_.y), a[3] * bfhi(gw_.y)}; }
                        if constexpr (MODE == 1) { const u32x2 gw_ = *(const u32x2*)(G + row * 4096 + 2048 + col); const f32x4 t = *(const f32x4*)(T1 + o);
                            u32x2 w; w.x = pk2(t[0] + a[0] * bflo(gw_.x), t[1] + a[1] * bfhi(gw_.x)); w.y = pk2(t[2] + a[2] * bflo(gw_.y), t[3] + a[3] * bfhi(gw_.y)); *(u32x2*)(OB + o) = w; }
                        if constexpr (MODE == 2) { const f32x4 x = *(const f32x4*)(X + o); *(f32x4*)(OUT + o) = x * ALPHA + a; }
                        if constexpr (MODE == 3) { *(f32x4*)(T1 + o) = a; }
                        if constexpr (MODE == 4) { const f32x4 x = *(const f32x4*)(X + o), e = *(const f32x4*)(T1 + o), b = *(const f32x4*)(bias + col);
                            *(f32x4*)(OUT + o) = (f32x4){x[0] + fsigmoid(a[0] + b[0]) * e[0], x[1] + fsigmoid(a[1] + b[1]) * e[1], x[2] + fsigmoid(a[2] + b[2]) * e[2], x[3] + fsigmoid(a[3] + b[3]) * e[3]}; }
                    } }
    }
};

struct Args { const float* in[N_IN]; float* out; unsigned char* ws; int ph_lo, ph_hi; };
struct Frame { LAS unsigned char* lds; int tid, lane, wave, vcu, G; const float* const* in; unsigned char* ws; float* out; };
__device__ __forceinline__ float wave_sum(float v) {
#pragma unroll
    for (int o = 1; o < 64; o <<= 1) v += __shfl_xor(v, o);
    return v;
}
__device__ __forceinline__ void p0_transpose_item(const float* W, int K, int N, bf16_t* WT, int dst_row0, int k0, int n0, LAS float* scr, int lane) {
#pragma unroll 8
    for (int i = 0; i < 32; ++i) { const int kk = 2 * i + (lane >> 5); scr[kk * 33 + (lane & 31)] = W[(size_t)(k0 + kk) * N + n0 + (lane & 31)]; }
    LDS_WAIT(); asm volatile("" ::: "memory");
    const int c = lane & 7;
#pragma unroll
    for (int j = 0; j < 4; ++j) { const int n = (lane >> 3) + 8 * j; const LAS float* s = scr + (8 * c) * 33 + n;
        u32x4 o; o.x = pk2(s[0 * 33], s[1 * 33]); o.y = pk2(s[2 * 33], s[3 * 33]); o.z = pk2(s[4 * 33], s[5 * 33]); o.w = pk2(s[6 * 33], s[7 * 33]);
        *(GAS u32x4*)(WT + (size_t)(dst_row0 + n) * K + k0 + 8 * c) = o; }
    LDS_WAIT(); asm volatile("" ::: "memory");
}
__device__ __forceinline__ int win_dst_row(int col) {
    if (col < 1024) return (col >> 7) * 256 + (col & 127);
    if (col < 2048) return ((col - 1024) >> 7) * 256 + 128 + (col & 127);
    if (col < 4096) return col;
    if (col < 5120) return col + 4096;
    return col - 1024;
}
__device__ __forceinline__ void p0_transpose_matrix(Frame& F, const float* W, int K, int N, bf16_t* WT, bool is_win, int& it0, LAS float* scr) {
    const int gw = F.vcu * NWAVES + F.wave, NGW = F.G * NWAVES, nblk = N / 32, nitems = (K / 64) * nblk;
    int first = gw - (it0 % NGW); if (first < 0) first += NGW;
    for (int r = first; r < nitems; r += NGW) { const int kb = r / nblk, nb = r % nblk, n0 = 32 * nb; p0_transpose_item(W, K, N, WT, is_win ? win_dst_row(n0) : n0, 64 * kb, n0, scr, F.lane); }
    it0 += nitems;
}
__device__ __forceinline__ void p0_cvt(Frame& F, const float* src, bf16_t* dst, size_t n) {
    const size_t gt = (size_t)F.vcu * NTHREADS + F.tid, NGT = (size_t)F.G * NTHREADS;
    for (size_t i = gt * 8; i < n; i += NGT * 8) { const f32x4 a = *(const GAS f32x4*)(src + i), b = *(const GAS f32x4*)(src + i + 4);
        u32x4 w; w.x = pk2(a[0], a[1]); w.y = pk2(a[2], a[3]); w.z = pk2(b[0], b[1]); w.w = pk2(b[2], b[3]); *(GAS u32x4*)(dst + i) = w; }
}
__device__ __forceinline__ void p0_row_fp8(const float* src, unsigned char* dst, float* inv, int lane) {
    f32x4 v[8]; float am = 0.f;
#pragma unroll
    for (int j = 0; j < 8; ++j) { v[j] = ((const GAS f32x4*)src)[lane + 64 * j]; am = fmaxf(fmaxf(am, fmaxf(fabsf(v[j].x), fabsf(v[j].y))), fmaxf(fabsf(v[j].z), fabsf(v[j].w))); }
#pragma unroll
    for (int o = 1; o < 64; o <<= 1) am = fmaxf(am, __shfl_xor(am, o));
    const float sc = am > 0.f ? 256.0f / am : 1.0f;
#pragma unroll
    for (int j = 0; j < 8; ++j) { int p = 0; p = __builtin_amdgcn_cvt_pk_fp8_f32(v[j].x * sc, v[j].y * sc, p, false); p = __builtin_amdgcn_cvt_pk_fp8_f32(v[j].z * sc, v[j].w * sc, p, true);
        ((GAS unsigned*)dst)[lane + 64 * j] = (unsigned)p; }
    if (lane == 0) *inv = am > 0.f ? am * (1.0f / 256.0f) : 1.0f;
}
__device__ __forceinline__ void p0_prologue(Frame& F) {
    LAS float* scr = (LAS float*)(F.lds + F.wave * 16384);
    int it0 = 0;
    p0_transpose_matrix(F, F.in[I_WIN], DM, IN_COLS, (bf16_t*)(F.ws + WS_WINT), true, it0, scr);
    p0_transpose_matrix(F, F.in[I_CWOUT], CONV_CH, DM, (bf16_t*)(F.ws + WS_WCT), false, it0, scr);
    p0_transpose_matrix(F, F.in[I_AWO], 1024, DM, (bf16_t*)(F.ws + WS_WOT), false, it0, scr);
    p0_transpose_matrix(F, F.in[I_WOUT], DM, DM, (bf16_t*)(F.ws + WS_WOUTT), false, it0, scr);
    p0_transpose_matrix(F, F.in[I_PWQ], DM, DM, (bf16_t*)(F.ws + WS_WQT), false, it0, scr);
    p0_transpose_matrix(F, F.in[I_PLEWG], DM, DM, (bf16_t*)(F.ws + WS_WPGT), false, it0, scr);
    p0_transpose_matrix(F, F.in[I_PLEWP], P_DIM, DM, (bf16_t*)(F.ws + WS_WPT), false, it0, scr);
    p0_cvt(F, F.in[I_X], (bf16_t*)(F.ws + WS_XB), (size_t)MTOK * DM);
    p0_cvt(F, F.in[I_P], (bf16_t*)(F.ws + WS_PB), (size_t)MTOK * P_DIM);
    p0_cvt(F, F.in[I_PSK], (bf16_t*)(F.ws + WS_SK), (size_t)PH * 2 * PNK * PHALF);
    { const int gw = F.vcu * NWAVES + F.wave, NGW = F.G * NWAVES;
      for (int r = gw; r < 2 * NEXP; r += NGW) { const int tb = r >= NEXP, e = r - tb * NEXP;
          p0_row_fp8(F.in[tb ? I_PV : I_PU] + (size_t)e * DM, F.ws + (tb ? WS_VB : WS_UB) + (size_t)e * DM, (float*)(F.ws + (tb ? WS_VSC : WS_USC)) + e, F.lane); } }
}


__device__ __forceinline__ void ln_row_2048(const float* zrow, const float* g, const float* b, float* yf, bf16_t* yb, int lane) {
    const GAS f32x4* zr = (const GAS f32x4*)zrow + lane;
    f32x4 v[8]; float s = 0.f;
#pragma unroll
    for (int j = 0; j < 8; ++j) { v[j] = zr[64 * j]; s += (v[j].x + v[j].y) + (v[j].z + v[j].w); }
    const float mean = wave_sum(s) * (1.f / DM); float s2 = 0.f;
#pragma unroll
    for (int j = 0; j < 8; ++j) { v[j] = v[j] - mean; s2 += (v[j].x * v[j].x + v[j].y * v[j].y) + (v[j].z * v[j].z + v[j].w * v[j].w); }
    const float rstd = __builtin_amdgcn_rsqf(wave_sum(s2) * (1.f / DM) + LN_EPS);
#pragma unroll
    for (int j = 0; j < 8; ++j) { const f32x4 gg = ((const GAS f32x4*)g + lane)[64 * j], bb = ((const GAS f32x4*)b + lane)[64 * j]; const f32x4 y = v[j] * rstd * gg + bb;
        ((GAS f32x4*)yf + lane)[64 * j] = y; u32x2 w; w.x = pk2(y.x, y.y); w.y = pk2(y.z, y.w); ((GAS u32x2*)yb + lane)[64 * j] = w; }
}


__device__ __forceinline__ float dot2_bf16(unsigned w, unsigned x, float acc) { return __builtin_amdgcn_fdot2_f32_bf16(__builtin_bit_cast(bf16x2_t, w), __builtin_bit_cast(bf16x2_t, x), acc, false); }
__device__ __forceinline__ float dpp_row_shr(float v, int n) {
    const int iv = __builtin_bit_cast(int, v); int r;
    switch (n) { case 1: r = __builtin_amdgcn_update_dpp(0, iv, 0x111, 0xf, 0xf, true); break; case 2: r = __builtin_amdgcn_update_dpp(0, iv, 0x112, 0xf, 0xf, true); break;
                 case 4: r = __builtin_amdgcn_update_dpp(0, iv, 0x114, 0xf, 0xf, true); break; default: r = __builtin_amdgcn_update_dpp(0, iv, 0x118, 0xf, 0xf, true); break; }
    return __builtin_bit_cast(float, r);
}
__device__ __forceinline__ float wave_total(float v) {
    v += dpp_row_shr(v, 1); v += dpp_row_shr(v, 2); v += dpp_row_shr(v, 4); v += dpp_row_shr(v, 8);
    v += __builtin_bit_cast(float, __builtin_amdgcn_update_dpp(0, __builtin_bit_cast(int, v), 0x142, 0xa, 0xf, false));
    v += __builtin_bit_cast(float, __builtin_amdgcn_update_dpp(0, __builtin_bit_cast(int, v), 0x143, 0xc, 0xf, false));
    return __builtin_bit_cast(float, __builtin_amdgcn_readlane(__builtin_bit_cast(int, v), 63));
}
__device__ __forceinline__ float gelu_fast(float h) {
    const float u = 1.5957691216057308f * (h + 0.044715f * h * h * h);
    return h * __builtin_amdgcn_rcpf(1.0f + __builtin_amdgcn_exp2f(-LOG2E * u));
}
__device__ __forceinline__ void p8_token(const float* x1f_row, const int* ids, const float* gwt, const unsigned char* U8, const unsigned char* V8, const float* usc, const float* vsc,
                                         const float* g2, const float* b2, float* x2f_row, bf16_t* x2b_row, int lane) {
    const int id_lo = ids[lane], id_hi = ids[lane + 64]; const float g_lo = gwt[lane], g_hi = gwt[lane + 64];
    f32x4 xf[2][4];
#pragma unroll
    for (int c = 0; c < 2; ++c)
#pragma unroll
        for (int k = 0; k < 4; ++k) xf[c][k] = ((const GAS f32x4*)x1f_row)[4 * (lane + 64 * c) + k];
    float w_lo = 0.f, w_hi = 0.f;
    for (int half = 0; half < 2; ++half) {
        const int idr = half ? id_hi : id_lo; const float gr = half ? g_hi : g_lo; float wr_ = 0.f;
        for (int jb = 0; jb < 8; ++jb) {
            u32x4 r[8][2]; float isc[8];
#pragma unroll
            for (int jj = 0; jj < 8; ++jj) { const int id = __builtin_amdgcn_readlane(idr, jb * 8 + jj); const GAS u32x4* rp = (const GAS u32x4*)(U8 + (size_t)id * DM) + lane;
                r[jj][0] = rp[0]; r[jj][1] = rp[64]; isc[jj] = usc[id]; }
#pragma unroll
            for (int jj = 0; jj < 8; ++jj) { f32x2 a0 = {0.f, 0.f}, a1 = {0.f, 0.f};
#pragma unroll
                for (int c = 0; c < 2; ++c)
#pragma unroll
                    for (int k = 0; k < 4; ++k) { const int dw = (int)r[jj][c][k]; const f32x4 xv = xf[c][k];
                        a0 = __builtin_amdgcn_cvt_pk_f32_fp8(dw, false) * (f32x2){xv.x, xv.y} + a0; a1 = __builtin_amdgcn_cvt_pk_f32_fp8(dw, true) * (f32x2){xv.z, xv.w} + a1; }
                const float h = wave_total((a0.x + a0.y) + (a1.x + a1.y)) * isc[jj];
                const float gj = __builtin_bit_cast(float, __builtin_amdgcn_readlane(__builtin_bit_cast(int, gr), jb * 8 + jj));
                const float wv = gj * gelu_fast(h);
                wr_ = (lane == jb * 8 + jj) ? wv : wr_; }
        }
        if (half) w_hi = wr_; else w_lo = wr_;
    }
    f32x2 acc[2][4][2];
#pragma unroll
    for (int c = 0; c < 2; ++c)
#pragma unroll
        for (int k = 0; k < 4; ++k) { acc[c][k][0] = (f32x2){0.f, 0.f}; acc[c][k][1] = (f32x2){0.f, 0.f}; }
    for (int half = 0; half < 2; ++half) {
        const int idr = half ? id_hi : id_lo; const float wr_ = half ? w_hi : w_lo;
        for (int jb = 0; jb < 8; ++jb) {
            u32x4 r[8][2]; float isc[8];
#pragma unroll
            for (int jj = 0; jj < 8; ++jj) { const int id = __builtin_amdgcn_readlane(idr, jb * 8 + jj); const GAS u32x4* rp = (const GAS u32x4*)(V8 + (size_t)id * DM) + lane;
                r[jj][0] = rp[0]; r[jj][1] = rp[64]; isc[jj] = vsc[id]; }
#pragma unroll
            for (int jj = 0; jj < 8; ++jj) { const float w = __builtin_bit_cast(float, __builtin_amdgcn_readlane(__builtin_bit_cast(int, wr_), jb * 8 + jj)) * isc[jj]; const f32x2 w2 = {w, w};
#pragma unroll
                for (int c = 0; c < 2; ++c)
#pragma unroll
                    for (int k = 0; k < 4; ++k) { const int dw = (int)r[jj][c][k];
                        acc[c][k][0] = __builtin_amdgcn_cvt_pk_f32_fp8(dw, false) * w2 + acc[c][k][0]; acc[c][k][1] = __builtin_amdgcn_cvt_pk_f32_fp8(dw, true) * w2 + acc[c][k][1]; } }
        }
    }
    float s = 0.f;
#pragma unroll
    for (int c = 0; c < 2; ++c)
#pragma unroll
        for (int k = 0; k < 4; ++k) { const f32x4 xv = xf[c][k];
            acc[c][k][0] = acc[c][k][0] + (f32x2){xv.x, xv.y} * ALPHA; acc[c][k][1] = acc[c][k][1] + (f32x2){xv.z, xv.w} * ALPHA;
            s += (acc[c][k][0].x + acc[c][k][0].y) + (acc[c][k][1].x + acc[c][k][1].y); }
    const float mean = wave_total(s) * (1.f / DM); float s2 = 0.f;
#pragma unroll
    for (int c = 0; c < 2; ++c)
#pragma unroll
        for (int k = 0; k < 4; ++k) { acc[c][k][0] = acc[c][k][0] - mean; acc[c][k][1] = acc[c][k][1] - mean;
            s2 += (acc[c][k][0].x * acc[c][k][0].x + acc[c][k][0].y * acc[c][k][0].y) + (acc[c][k][1].x * acc[c][k][1].x + acc[c][k][1].y * acc[c][k][1].y); }
    const float rstd = __builtin_amdgcn_rsqf(wave_total(s2) * (1.f / DM) + LN_EPS);
#pragma unroll
    for (int c = 0; c < 2; ++c) { unsigned pkw[8];
#pragma unroll
        for (int k = 0; k < 4; ++k) { const int ci = 4 * (lane + 64 * c) + k; const f32x4 gg = ((const GAS f32x4*)g2)[ci], bb = ((const GAS f32x4*)b2)[ci];
            const f32x4 y = {acc[c][k][0].x * rstd * gg.x + bb.x, acc[c][k][0].y * rstd * gg.y + bb.y, acc[c][k][1].x * rstd * gg.z + bb.z, acc[c][k][1].y * rstd * gg.w + bb.w};
            ((GAS f32x4*)x2f_row)[ci] = y; pkw[2 * k] = pk2(y.x, y.y); pkw[2 * k + 1] = pk2(y.z, y.w); }
        ((GAS u32x4*)x2b_row)[2 * (lane + 64 * c)] = (u32x4){pkw[0], pkw[1], pkw[2], pkw[3]}; ((GAS u32x4*)x2b_row)[2 * (lane + 64 * c) + 1] = (u32x4){pkw[4], pkw[5], pkw[6], pkw[7]}; }
}

__device__ __forceinline__ int f2key(float v) { const int b = __builtin_bit_cast(int, v); return b ^ ((b >> 31) & 0x7fffffff); }
__device__ __forceinline__ float key2f(int k) { const int b = k ^ ((k >> 31) & 0x7fffffff); return __builtin_bit_cast(float, b); }
__device__ __forceinline__ void cmpx(int& a, int& b) { const int mx = a > b ? a : b, mn = a > b ? b : a; a = mx; b = mn; }
template <int N> __device__ __forceinline__ void bitonic_merge_desc(int (&k)[N]) {
#pragma unroll
    for (int stride = N / 2; stride > 0; stride >>= 1)
#pragma unroll
        for (int i = 0; i < N; ++i) { const int j = i ^ stride; if (j > i) cmpx(k[i], k[j]); }
}
template <int N> __device__ __forceinline__ void bitonic_sort_desc(int (&k)[N]) {
#pragma unroll
    for (int size = 2; size <= N; size <<= 1)
#pragma unroll
        for (int stride = size >> 1; stride > 0; stride >>= 1)
#pragma unroll
            for (int i = 0; i < N; ++i) { const int j = i ^ stride; if (j > i) { if ((i & size) == 0 || size == N) cmpx(k[i], k[j]); else cmpx(k[j], k[i]); } }
}
__device__ __forceinline__ void top16_merge(int (&a)[16], const int (&b)[16]) {
#pragma unroll
    for (int i = 0; i < 16; ++i) a[i] = a[i] > b[15 - i] ? a[i] : b[15 - i];
    bitonic_merge_desc<16>(a);
}
__device__ __forceinline__ void top16_of_64(int (&g0)[16], int (&g1)[16], int (&g2)[16], int (&g3)[16]) {
    bitonic_sort_desc<16>(g0); bitonic_sort_desc<16>(g1); bitonic_sort_desc<16>(g2); bitonic_sort_desc<16>(g3);
    top16_merge(g0, g1); top16_merge(g2, g3); top16_merge(g0, g2);
}
__device__ __forceinline__ void p7_tile(const bf16_t* qp, const bf16_t* SK, int* ids, float* gwt, int tok0, int h, LAS int* scr  , int lane) {
    const int r32 = lane & 31, hi = lane >> 5;
    int top[2][16];
#pragma unroll
    for (int c = 0; c < 2; ++c) {
        const int hc = h * 2 + c;
        f32x16 acc[4];
#pragma unroll
        for (int nb = 0; nb < 4; ++nb) acc[nb] = f32x16{};
        const bf16_t* qrow = qp + (size_t)(tok0 + r32) * DM + hc * 128 + 8 * hi;
        const bf16_t* krow = SK + ((size_t)hc * 128 + r32) * 128 + 8 * hi;
#pragma unroll 2
        for (int ks = 0; ks < 8; ++ks) {
            const bf16x8 qf = *(const GAS bf16x8*)(qrow + 16 * ks);
#pragma unroll
            for (int nb = 0; nb < 4; ++nb) { const bf16x8 kf = *(const GAS bf16x8*)(krow + (size_t)nb * 32 * 128 + 16 * ks); acc[nb] = __builtin_amdgcn_mfma_f32_32x32x16_bf16(kf, qf, acc[nb], 0, 0, 0); }
        }
        int g[4][16];
#pragma unroll
        for (int nb = 0; nb < 4; ++nb)
#pragma unroll
            for (int r = 0; r < 16; ++r) { const int n = 32 * nb + 8 * (r >> 2) + 4 * hi + (r & 3); g[nb][r] = (f2key(acc[nb][r]) & ~0x7f) | (127 - n); }
        top16_of_64(g[0], g[1], g[2], g[3]);
        int lo_[16], hi_[16];
#pragma unroll
        for (int i = 0; i < 16; ++i) { auto rr = __builtin_amdgcn_permlane32_swap((unsigned)g[0][i], (unsigned)g[0][i], false, false); lo_[i] = (int)rr[0]; hi_[i] = (int)rr[1]; }
        top16_merge(lo_, hi_);
#pragma unroll
        for (int i = 0; i < 16; ++i) top[c][i] = lo_[i];
    }
#pragma unroll
    for (int c = 0; c < 2; ++c)
#pragma unroll
        for (int i = 0; i < 16; ++i) scr[(16 * c + i) * 64 + lane] = 127 - (top[c][i] & 0x7f);
    int cg[4][16];
    {
        int cnt = 0;
#pragma unroll
        for (int i = 0; i < 16; ++i)
#pragma unroll
            for (int j = 0; j < 16; ++j) if ((i + 1) * (j + 1) <= 16) {
                const float sum = key2f(top[0][i] & ~0x7f) + key2f(top[1][j] & ~0x7f);
                cg[cnt >> 4][cnt & 15] = (f2key(sum) & ~0xff) | (255 - ((i << 4) | j)); ++cnt; }
#pragma unroll
        for (int q = 50; q < 64; ++q) cg[q >> 4][q & 15] = (int)0x80000000;
    }
    top16_of_64(cg[0], cg[1], cg[2], cg[3]);
    LDS_WAIT();
    float e[16]; float sum = 0.f; const float smax = key2f(cg[0][0] & ~0xff);
#pragma unroll
    for (int r = 0; r < 16; ++r) { e[r] = __builtin_amdgcn_exp2f((key2f(cg[0][r] & ~0xff) - smax) * LOG2E); sum += e[r]; }
    const float inv = __builtin_amdgcn_rcpf(sum);
    if (hi == 0) {
        int* ip = ids + (size_t)(tok0 + r32) * 128 + h * 16; float* gp = gwt + (size_t)(tok0 + r32) * 128 + h * 16;
#pragma unroll
        for (int r = 0; r < 16; ++r) { const int pay = 255 - (cg[0][r] & 0xff); const int i0 = scr[(pay >> 4) * 64 + lane], i1 = scr[(16 + (pay & 15)) * 64 + lane];
            ip[r] = i0 * PNK + i1; gp[r] = e[r] * inv; }
    }
    LDS_WAIT();
}


__device__ __forceinline__ float dpp_scan64(float v) {
    v += dpp_row_shr(v, 1); v += dpp_row_shr(v, 2); v += dpp_row_shr(v, 4); v += dpp_row_shr(v, 8);
    v += __builtin_bit_cast(float, __builtin_amdgcn_update_dpp(0, __builtin_bit_cast(int, v), 0x142, 0xa, 0xf, false));
    v += __builtin_bit_cast(float, __builtin_amdgcn_update_dpp(0, __builtin_bit_cast(int, v), 0x143, 0xc, 0xf, false));
    return v;
}
template <int R> __device__ __forceinline__ void conv_rows(f32x2 (&y)[16], const f32x2 (&w)[31], const unsigned (&xin)[46]) {
    const f32x2 xv = {bflo(xin[R]), bfhi(xin[R])};
    constexpr int tlo = R - 30 < 0 ? 0 : R - 30, thi = R < 16 ? R : 15;
#pragma unroll
    for (int t = tlo; t <= thi; ++t) y[t] = y[t] + w[R - t] * xv;
    if constexpr (R + 1 < 46) conv_rows<R + 1>(y, w, xin);
}
__device__ __forceinline__ void p2_conv_item(const bf16_t* hglu, const float* dww, const float* dwb, const float* lng, const float* lnb, bf16_t* hc, int tok0, LAS float* red  , int tid) {
    const int c0 = 2 * tid, s0 = tok0 % SEQ, lane = tid & 63, wave = tid >> 6;
    unsigned xin[46];
#pragma unroll
    for (int r = 0; r < 46; ++r) { const bool ok = (s0 - 30 + r) >= 0; xin[r] = ok ? *(const GAS unsigned*)(hglu + (size_t)(tok0 - 30 + r) * CONV_CH + c0) : 0u; }
    f32x2 w[31];
#pragma unroll
    for (int j = 0; j < 31; ++j) w[j] = *(const GAS f32x2*)(dww + j * CONV_CH + c0);
    const f32x2 bias = *(const GAS f32x2*)(dwb + c0);
    f32x2 y[16];
#pragma unroll
    for (int t = 0; t < 16; ++t) y[t] = bias;
    conv_rows<0>(y, w, xin);
#pragma unroll
    for (int t = 0; t < 16; ++t) { const float ps = dpp_scan64(y[t].x + y[t].y), pq = dpp_scan64(y[t].x * y[t].x + y[t].y * y[t].y);
        if (lane == 63) { red[(2 * t) * 8 + wave] = ps; red[(2 * t + 1) * 8 + wave] = pq; } }
    LDS_WAIT(); __syncthreads();
    if (tid < 32) { float a = 0.f;
#pragma unroll
        for (int k = 0; k < 8; ++k) a += red[tid * 8 + k];
        red[256 + tid] = a; }
    LDS_WAIT(); __syncthreads();
    const f32x2 g = *(const GAS f32x2*)(lng + c0), bb = *(const GAS f32x2*)(lnb + c0);
#pragma unroll
    for (int t = 0; t < 16; ++t) { const float mean = red[256 + 2 * t] * (1.f / CONV_CH), ex2 = red[256 + 2 * t + 1] * (1.f / CONV_CH);
        const float rstd = __builtin_amdgcn_rsqf(ex2 - mean * mean + LN_EPS);
        const float v0 = (y[t].x - mean) * rstd * g.x + bb.x, v1 = (y[t].y - mean) * rstd * g.y + bb.y;
        *(GAS unsigned*)(hc + (size_t)(tok0 + t) * CONV_CH + c0) = pk2(v0 * fsigmoid(v0), v1 * fsigmoid(v1)); }
    __syncthreads();
}

constexpr int AT_KBYTES = 8192, AT_VPITCH = 136, AT_VBYTES = 128 * AT_VPITCH, AT_BUF = 2 * AT_KBYTES + AT_VBYTES;
constexpr int AT_WSF = 2 * AT_BUF;
constexpr int AT_XCH = 0;
static_assert(AT_WSF + 8 * 128 <= RING_BYTES && 4 * 32 * 128 * 4 <= AT_WSF, "attention LDS map");
__device__ __forceinline__ int crow(int r, int hi) { return (r & 3) + 8 * (r >> 2) + 4 * hi; }
__device__ __forceinline__ void p2_attn_unit(const bf16_t* Qb, const bf16_t* Kb, const bf16_t* VT, bf16_t* on, const float* subg, float lam, int b, int h, int qb, LAS unsigned char* lds, int tid) {
    const int lane = tid & 63, r32 = lane & 31, hi = lane >> 5, wid = __builtin_amdgcn_readfirstlane(tid >> 6), map = wid >> 2, wq = wid & 3;
    const size_t rowb = (size_t)b * SEQ; const int q0 = 128 * qb + 32 * wq;
    const int NT = 2 * (qb + 1);
    const float sl = __builtin_amdgcn_exp2f(-(float)(h + 1)) * LOG2E;
    const bf16_t* kg[2]; int kl[2]; const bf16_t* vg[2]; int vl[2];
#pragma unroll
    for (int i = 0; i < 2; ++i) { const int p = tid + 512 * i, mp = p >> 9, key = p & 63, ch = (p >> 6) & 7;
        kg[i] = Kb + (rowb + key) * 1024 + h * 128 + mp * 64 + 8 * ch; kl[i] = mp * AT_KBYTES + ch * 1024 + key * 16;
        const int row = p >> 3, vc = p & 7; vg[i] = VT + (size_t)(h * 128 + row) * MTOK + rowb + 8 * vc; vl[i] = 2 * AT_KBYTES + row * AT_VPITCH + vc * 16; }
    u32x4 ks[2], vs[2];
#define AT_LOAD(t) do { _Pragma("unroll") for (int i_ = 0; i_ < 2; ++i_) { ks[i_] = *(const GAS u32x4*)(kg[i_] + (size_t)(t) * 64 * 1024); vs[i_] = *(const GAS u32x4*)(vg[i_] + (t) * 64); } } while (0)
#define AT_STORE(bufo) do { _Pragma("unroll") for (int i_ = 0; i_ < 2; ++i_) { *(LAS u32x4*)(lds + (bufo) + kl[i_]) = ks[i_]; \
        *(LAS u32x2*)(lds + (bufo) + vl[i_]) = (u32x2){vs[i_].x, vs[i_].y}; *(LAS u32x2*)(lds + (bufo) + vl[i_] + 8) = (u32x2){vs[i_].z, vs[i_].w}; } } while (0)
    AT_LOAD(0);
    bf16x8 qr[4];
#pragma unroll
    for (int d0 = 0; d0 < 4; ++d0) qr[d0] = *(const GAS bf16x8*)(Qb + (rowb + q0 + r32) * 1024 + h * 128 + map * 64 + 16 * d0 + 8 * hi);
    f32x16 o[4];
#pragma unroll
    for (int d0 = 0; d0 < 4; ++d0) o[d0] = f32x16{};
    float mrun = 0.f, lsum = 0.f;
    LAS float* wsf = (LAS float*)(lds + AT_WSF) + wid * 32;
    AT_STORE(0);
    LDS_WAIT(); __syncthreads();
    for (int t = 0; t < NT; ++t) {
        const int bufo = (t & 1) * AT_BUF;
        if (t + 1 < NT) AT_LOAD(t + 1);
        f32x16 x[2];
        { const float base = sl * (float)(64 * t + 4 * hi) - mrun;
#pragma unroll
          for (int r = 0; r < 16; ++r) { x[0][r] = fmaf(sl, (float)crow(r, 0), base); x[1][r] = fmaf(sl, (float)(crow(r, 0) + 32), base); } }
        const LAS unsigned char* kb_ = lds + bufo + map * AT_KBYTES + hi * 1024 + r32 * 16;
#pragma unroll
        for (int d0 = 0; d0 < 4; ++d0) {
            const bf16x8 k0 = *(const LAS bf16x8*)(kb_ + d0 * 2048), k1 = *(const LAS bf16x8*)(kb_ + d0 * 2048 + 512);
            x[0] = __builtin_amdgcn_mfma_f32_32x32x16_bf16(k0, qr[d0], x[0], 0, 0, 0);
            x[1] = __builtin_amdgcn_mfma_f32_32x32x16_bf16(k1, qr[d0], x[1], 0, 0, 0);
        }
        if (t >= NT - 2) {
            const int qrel = 32 * wq + r32, kb0 = 64 * (t - (NT - 2));
#pragma unroll
            for (int r = 0; r < 16; ++r) { const int kr = kb0 + crow(r, hi); if (kr > qrel) x[0][r] = -INFINITY; if (kr + 32 > qrel) x[1][r] = -INFINITY; }
        }
        float rm = fmaxf(x[0][0], x[1][0]);
#pragma unroll
        for (int r = 1; r < 16; ++r) rm = fmaxf(rm, fmaxf(x[0][r], x[1][r]));
        { auto rr = __builtin_amdgcn_permlane32_swap(__float_as_uint(rm), __float_as_uint(rm), false, false); rm = fmaxf(__uint_as_float(rr[0]), __uint_as_float(rr[1])); }
        const bool resc = (t == 0) || __any(rm > 6.0f);
        if (resc) {
            const float dl = (t == 0) ? rm : fmaxf(rm, 0.f); mrun += dl;
#pragma unroll
            for (int r = 0; r < 16; ++r) { x[0][r] -= dl; x[1][r] -= dl; }
            if (t > 0) { const float f = __builtin_amdgcn_exp2f(-dl); lsum *= f; if (hi == 0) wsf[r32] = f; LDS_WAIT();
#pragma unroll
                for (int r = 0; r < 16; ++r) { const float fr_ = wsf[crow(r, hi)];
#pragma unroll
                    for (int d0 = 0; d0 < 4; ++d0) o[d0][r] *= fr_; } }
        }
        u32x4 pa[4];
#pragma unroll
        for (int kb = 0; kb < 2; ++kb) {
#pragma unroll
            for (int r = 0; r < 16; ++r) { x[kb][r] = __builtin_amdgcn_exp2f(x[kb][r]); lsum += x[kb][r]; }
#pragma unroll
            for (int sp = 0; sp < 2; ++sp) pa[2 * kb + sp] = (u32x4){pk2(x[kb][8 * sp + 0], x[kb][8 * sp + 1]), pk2(x[kb][8 * sp + 2], x[kb][8 * sp + 3]), pk2(x[kb][8 * sp + 4], x[kb][8 * sp + 5]), pk2(x[kb][8 * sp + 6], x[kb][8 * sp + 7])};
        }
        const LAS unsigned char* vb_ = lds + bufo + 2 * AT_KBYTES + r32 * AT_VPITCH + hi * 8;
#pragma unroll
        for (int d0 = 0; d0 < 4; ++d0)
#pragma unroll
            for (int s_ = 0; s_ < 4; ++s_) { const u32x2 lo = *(const LAS u32x2*)(vb_ + d0 * 32 * AT_VPITCH + s_ * 32), hh = *(const LAS u32x2*)(vb_ + d0 * 32 * AT_VPITCH + s_ * 32 + 16);
                const u32x4 vf = {lo.x, lo.y, hh.x, hh.y};
                o[d0] = __builtin_amdgcn_mfma_f32_32x32x16_bf16(__builtin_bit_cast(bf16x8, pa[s_]), __builtin_bit_cast(bf16x8, vf), o[d0], 0, 0, 0); }
        if (t + 1 < NT) AT_STORE(((t + 1) & 1) * AT_BUF);
        LDS_WAIT(); __syncthreads();
    }
    { auto rr = __builtin_amdgcn_permlane32_swap(__float_as_uint(lsum), __float_as_uint(lsum), false, false); lsum = __uint_as_float(rr[0]) + __uint_as_float(rr[1]); }
    if (hi == 0) wsf[r32] = ((map == 0) ? 1.0f : lam) / lsum;
    LDS_WAIT();
#pragma unroll
    for (int r = 0; r < 16; ++r) { const float il = wsf[crow(r, hi)];
#pragma unroll
        for (int d0 = 0; d0 < 4; ++d0) o[d0][r] *= il; }
    LAS float* xch = (LAS float*)(lds + AT_XCH) + wq * (32 * 128);
    if (map == 1) {
#pragma unroll
        for (int r = 0; r < 16; ++r)
#pragma unroll
            for (int d0 = 0; d0 < 4; ++d0) xch[crow(r, hi) * 128 + 32 * d0 + r32] = o[d0][r];
    }
    LDS_WAIT(); __syncthreads();
    if (map == 0) {
        float ss[16];
#pragma unroll
        for (int r = 0; r < 16; ++r) { float a = 0.f;
#pragma unroll
            for (int d0 = 0; d0 < 4; ++d0) { o[d0][r] -= xch[crow(r, hi) * 128 + 32 * d0 + r32]; a += o[d0][r] * o[d0][r]; }
            ss[r] = a; }
#pragma unroll
        for (int r = 0; r < 16; ++r) { float a = ss[r]; a += __shfl_xor(a, 1); a += __shfl_xor(a, 2); a += __shfl_xor(a, 4); a += __shfl_xor(a, 8); a += __shfl_xor(a, 16);
            ss[r] = __builtin_amdgcn_rsqf(a * (1.f / 128.f) + LN_EPS) * (1.0f - LAM_INIT); }
        float gsub[4];
#pragma unroll
        for (int d0 = 0; d0 < 4; ++d0) gsub[d0] = subg[32 * d0 + r32];
#pragma unroll
        for (int r = 0; r < 16; ++r) { bf16_t* orow = on + (rowb + q0 + crow(r, hi)) * 1024 + h * 128 + r32;
#pragma unroll
            for (int d0 = 0; d0 < 4; ++d0) orow[32 * d0] = (bf16_t)f2bf(o[d0][r] * ss[r] * gsub[d0]); }
    }
    __syncthreads();
#undef AT_LOAD
#undef AT_STORE
}

constexpr int CW_BAR = 4096;
constexpr size_t CTL_ZERO_BYTES = 64 * 1024;
#ifndef REP_PHASE
#define REP_PHASE -1
#endif
#define REPS(k) for (int rep_ = 0; rep_ < ((REP_PHASE == (k)) ? 2 : 1); ++rep_)
enum { PH_P0 = 0, PH_P1, PH_P2, PH_P3, PH_P4, PH_P5, PH_P6, PH_P7, PH_P8, PH_P9, PH_END };

__global__ void __launch_bounds__(NTHREADS, 2) mk_fwd(Args args) {
    extern __shared__ __attribute__((aligned(16))) unsigned char lds_raw[];
    Frame F;
    F.lds = (LAS unsigned char*)lds_raw;
    F.tid = threadIdx.x; F.lane = F.tid & 63; F.wave = __builtin_amdgcn_readfirstlane(F.tid >> 6);
    F.G = gridDim.x; { const int bx = blockIdx.x; F.vcu = (F.G % 8 == 0) ? (bx % 8) * (F.G / 8) + bx / 8 : bx; }
    F.in = args.in; F.ws = args.ws; F.out = args.out;
    volatile LAS unsigned* MISC = (volatile LAS unsigned*)(F.lds + MISC_OFF);
    for (int u = F.tid; u < (LDS_BYTES - MISC_OFF) / 4; u += NTHREADS) MISC[u] = 0u;
    __syncthreads();
    const int lo = args.ph_lo, hi = args.ph_hi;
    XcdBarrier bar; bar.bar = (unsigned*)(F.ws + WS_CTL) + CW_BAR; bar.x = 0; bar.st = nullptr;
    if (hi - lo > 1) bar = xcd_barrier_post((unsigned*)(F.ws + WS_CTL) + CW_BAR, MISC + 8);
#define IN(k) (lo <= (k) && (k) < hi)
#define SEAM(k) do { if (IN(k) && IN((k) + 1)) xcd_barrier(bar); } while (0)
    unsigned char* ws = F.ws;
    if (IN(PH_P0)) { REPS(0) p0_prologue(F); SEAM(PH_P0); }
    if (IN(PH_P1)) { REPS(1) {
        { pg8::Gemm g{(const bf16_t*)(ws + WS_XB), (const bf16_t*)(ws + WS_WINT), DM, DM, DM}; pg8::StaticOrder S; S.init(MTOK, 8192, F.G, (int)blockIdx.x);
          EpiP1 E{(bf16_t*)(ws + WS_HGLU), (bf16_t*)(ws + WS_QB), (bf16_t*)(ws + WS_KB), (bf16_t*)(ws + WS_GT), F.in[I_BGATE]};
          pg8::gemm_phase<EpiP1>(F.lds, g, S, E); }
        { pg8::Gemm g{(const bf16_t*)(ws + WS_WINT) + (size_t)8192 * DM, (const bf16_t*)(ws + WS_XB), DM, DM, DM}; pg8::StaticOrder S; S.init(1024, MTOK, F.G, (int)blockIdx.x);
          EpiBf16 E{(bf16_t*)(ws + WS_VT), MTOK};
          pg8::gemm_phase<EpiBf16>(F.lds, g, S, E); }
        }
        SEAM(PH_P1);
    }

    if (IN(PH_P2)) { REPS(2) {
        int tid_ = F.tid; asm volatile("" : "+v"(tid_));
        for (int it = F.vcu * 2; it < MTOK / 16; it += F.G * 2) {
            p2_conv_item((const bf16_t*)(ws + WS_HGLU), F.in[I_DWW], F.in[I_DWB], F.in[I_CLNG], F.in[I_CLNB], (bf16_t*)(ws + WS_HC), it * 16, (LAS float*)F.lds, tid_);
            p2_conv_item((const bf16_t*)(ws + WS_HGLU), F.in[I_DWW], F.in[I_DWB], F.in[I_CLNG], F.in[I_CLNB], (bf16_t*)(ws + WS_HC), it * 16 + 16, (LAS float*)F.lds, tid_); }
        float lam;
        { float a = 0.f, c = 0.f; for (int i = 0; i < 64; ++i) { a += F.in[I_LQ1][i] * F.in[I_LK1][i]; c += F.in[I_LQ2][i] * F.in[I_LK2][i]; } lam = __expf(a) - __expf(c) + LAM_INIT; }
        for (int it = F.vcu; it < BATCH * AH * 8; it += F.G) { const int bh = it >> 3, s_ = it & 7;
            p2_attn_unit((const bf16_t*)(ws + WS_QB), (const bf16_t*)(ws + WS_KB), (const bf16_t*)(ws + WS_VT), (bf16_t*)(ws + WS_ON), F.in[I_SUBLN], lam, bh / AH, bh % AH, 15 - s_, F.lds, tid_);
            p2_attn_unit((const bf16_t*)(ws + WS_QB), (const bf16_t*)(ws + WS_KB), (const bf16_t*)(ws + WS_VT), (bf16_t*)(ws + WS_ON), F.in[I_SUBLN], lam, bh / AH, bh % AH, s_, F.lds, tid_); }
        }
        SEAM(PH_P2);
    }
    if (IN(PH_P3)) { REPS(3) {
        pg8::StaticOrder S; S.init(MTOK, DM, F.G, (int)blockIdx.x);
        { pg8::Gemm g{(const bf16_t*)(ws + WS_HC), (const bf16_t*)(ws + WS_WCT), 1024, 1024, 1024};
          EpiF32<0> E{(float*)(ws + WS_T1), (const bf16_t*)(ws + WS_GT), nullptr, nullptr, nullptr, nullptr}; pg8::gemm_phase<EpiF32<0>>(F.lds, g, S, E); }
        { pg8::Gemm g{(const bf16_t*)(ws + WS_ON), (const bf16_t*)(ws + WS_WOT), 1024, 1024, 1024};
          EpiF32<1> E{(float*)(ws + WS_T1), (const bf16_t*)(ws + WS_GT), (bf16_t*)(ws + WS_MIXED), nullptr, nullptr, nullptr}; pg8::gemm_phase<EpiF32<1>>(F.lds, g, S, E); }
        }
        SEAM(PH_P3);
    }
    if (IN(PH_P4)) { REPS(4) {
        pg8::StaticOrder S; S.init(MTOK, DM, F.G, (int)blockIdx.x);
        pg8::Gemm g{(const bf16_t*)(ws + WS_MIXED), (const bf16_t*)(ws + WS_WOUTT), DM, DM, DM};
        EpiF32<2> E{nullptr, nullptr, nullptr, F.in[I_X], (float*)(ws + WS_X1F), nullptr}; pg8::gemm_phase<EpiF32<2>>(F.lds, g, S, E);
        }
        SEAM(PH_P4);
    }
    if (IN(PH_P5)) { REPS(5) {
        const int gw = F.vcu * NWAVES + F.wave, NGW = F.G * NWAVES;
        for (int m = gw; m < MTOK; m += NGW) ln_row_2048((const float*)(ws + WS_X1F) + (size_t)m * DM, F.in[I_LN1G], F.in[I_LN1B], (float*)(ws + WS_X1F) + (size_t)m * DM, (bf16_t*)(ws + WS_X1B) + (size_t)m * DM, F.lane);
        }
        SEAM(PH_P5);
    }
    if (IN(PH_P6)) { REPS(6) {
        pg8::StaticOrder S; S.init(MTOK, DM, F.G, (int)blockIdx.x);
        pg8::Gemm g{(const bf16_t*)(ws + WS_X1B), (const bf16_t*)(ws + WS_WQT), DM, DM, DM};
        EpiBf16 E{(bf16_t*)(ws + WS_QP), DM}; pg8::gemm_phase<EpiBf16>(F.lds, g, S, E);
        }
        SEAM(PH_P6);
    }
    if (IN(PH_P7)) { REPS(7) {
        int lane_ = F.lane; asm volatile("" : "+v"(lane_));
        const int per = MTOK / F.G;
        for (int t0 = 0; t0 < per; t0 += 32)
            p7_tile((const bf16_t*)(ws + WS_QP), (const bf16_t*)(ws + WS_SK), (int*)(ws + WS_IDS), (float*)(ws + WS_GW), F.vcu * per + t0, F.wave, (LAS int*)(F.lds + F.wave * 8192), lane_);
        }
        SEAM(PH_P7);
    }
    if (IN(PH_P8)) { REPS(8) {
        int lane_ = F.lane; asm volatile("" : "+v"(lane_));
        const int per = MTOK / F.G;
        for (int k = F.wave; k < per; k += NWAVES) { const size_t m = (size_t)F.vcu * per + k;
            p8_token((const float*)(ws + WS_X1F) + m * DM, (const int*)(ws + WS_IDS) + m * 128, (const float*)(ws + WS_GW) + m * 128,
                     (const unsigned char*)(ws + WS_UB), (const unsigned char*)(ws + WS_VB), (const float*)(ws + WS_USC), (const float*)(ws + WS_VSC),
                     F.in[I_LN2G], F.in[I_LN2B], (float*)(ws + WS_X2F) + m * DM, (bf16_t*)(ws + WS_X2B) + m * DM, lane_); }
        }
        SEAM(PH_P8);
    }
    if (IN(PH_P9)) { REPS(9) {
        pg8::StaticOrder S; S.init(MTOK, DM, F.G, (int)blockIdx.x);
        { pg8::Gemm g{(const bf16_t*)(ws + WS_PB), (const bf16_t*)(ws + WS_WPT), P_DIM, P_DIM, P_DIM};
          EpiF32<3> E{(float*)(ws + WS_E), nullptr, nullptr, nullptr, nullptr, nullptr}; pg8::gemm_phase<EpiF32<3>>(F.lds, g, S, E); }
        { pg8::Gemm g{(const bf16_t*)(ws + WS_X2B), (const bf16_t*)(ws + WS_WPGT), DM, DM, DM};
          EpiF32<4> E{(float*)(ws + WS_E), nullptr, nullptr, (const float*)(ws + WS_X2F), F.out, F.in[I_PLEBG]}; pg8::gemm_phase<EpiF32<4>>(F.lds, g, S, E); }
        }
    }
#undef IN
#undef SEAM
}
extern "C" void kernel_launch(void* const* d_in, const int* in_sizes, int n_in, void* d_out, int out_size, void* d_ws, size_t ws_size, hipStream_t stream) {
    static int grid = 0;
    if (grid == 0) {
        if (n_in != N_IN || ws_size < WS_END) { fprintf(stderr, "kernel_launch: unexpected n_in %d / ws_size %zu\n", n_in, ws_size); grid = -1; return; }
        int dev = 0, cus = 0;
        if (hipGetDevice(&dev) != hipSuccess || hipDeviceGetAttribute(&cus, hipDeviceAttributeMultiprocessorCount, dev) != hipSuccess) { grid = -1; return; }
        if (hipFuncSetAttribute((const void*)mk_fwd, hipFuncAttributeMaxDynamicSharedMemorySize, LDS_BYTES) != hipSuccess) { fprintf(stderr, "kernel_launch: hipFuncSetAttribute failed\n"); grid = -1; return; }
        (void)hipGetLastError();
        grid = cus;
    }
    if (grid < 0) return;
    (void)hipMemsetAsync((unsigned char*)d_ws + WS_CTL, 0, CTL_ZERO_BYTES, stream);
    Args a{}; for (int i = 0; i < N_IN; ++i) a.in[i] = (const float*)d_in[i]; a.out = (float*)d_out; a.ws = (unsigned char*)d_ws;
    a.ph_lo = 0; a.ph_hi = PH_END;
    hipLaunchKernelGGL(mk_fwd, dim3(grid), dim3(NTHREADS), LDS_BYTES, stream, a);
}
```

```cpp
#include <hip/hip_runtime.h>
#include <cstdio>
#include <cstdint>
#include <cmath>

constexpr int DM = 2048, BATCH = 4, SEQ = 2048, MTOK = BATCH * SEQ;
constexpr int P_DIM = 256, CONV_CH = 1024, CONV_W = 31, AH = 8, AHD = 64, AVD = 128;
constexpr int PH = 8, PNK = 128, PHALF = 128, PTOPK = 16, NEXP = PNK * PNK;
constexpr int COL_CONV = 2048, COL_Q = 1024, COL_K = 1024, COL_V = 1024, COL_GATE = 4096, IN_COLS = 9216;
constexpr int OFF_Q = 2048, OFF_K = 3072, OFF_V = 4096, OFF_G = 5120;
constexpr float LN_EPS = 1e-5f;
constexpr float ALPHA = 1.189207115002721f;
constexpr float LAM_INIT = 0.2f;
constexpr float LOG2E = 1.4426950408889634f;
constexpr float QSCALE = 0.125f * LOG2E;

typedef unsigned short bf16_t;
__device__ __forceinline__ unsigned f2bf(float f) { unsigned u = __builtin_bit_cast(unsigned, f); return (u + 0x7fffu + ((u >> 16) & 1u)) >> 16; }
__device__ __forceinline__ float bf2f(unsigned h) { return __builtin_bit_cast(float, h << 16); }
__device__ __forceinline__ float sigmoidf_(float v) { return 1.0f / (1.0f + __expf(-v)); }
__device__ __forceinline__ float gelu_tanh(float v) { const float u = 0.7978845608028654f * (v + 0.044715f * v * v * v); return 0.5f * v * (1.0f + tanhf(u)); }

constexpr size_t MiB = 1u << 20;
constexpr size_t WS_CTL = 0;
constexpr size_t WS_SK = 1 * MiB;
constexpr size_t WS_PB = 2 * MiB;
constexpr size_t WS_WCT = 6 * MiB, WS_WOT = 10 * MiB, WS_WOUTT = 14 * MiB, WS_WQT = 22 * MiB, WS_WPGT = 30 * MiB, WS_WPT = 38 * MiB;
constexpr size_t WS_UB = 40 * MiB, WS_VB = 72 * MiB;
constexpr size_t WS_USC = 104 * MiB, WS_VSC = 104 * MiB + 65536;
constexpr size_t WS_XB = 168 * MiB;
constexpr size_t WS_MIXED = WS_XB, WS_X1B = WS_XB;
constexpr size_t WS_WINT = 200 * MiB;
constexpr size_t WS_HC = 200 * MiB, WS_ON = 216 * MiB, WS_QP = 200 * MiB, WS_X2B = 200 * MiB;
constexpr size_t WS_HGLU = 236 * MiB, WS_QB = 252 * MiB, WS_KB = 268 * MiB, WS_VT = 284 * MiB;
constexpr size_t WS_T1 = 236 * MiB;
constexpr size_t WS_X2F = 236 * MiB;
constexpr size_t WS_GT = 300 * MiB;
constexpr size_t WS_X1F = 300 * MiB;
constexpr size_t WS_E = 364 * MiB;
constexpr size_t WS_IDS = 364 * MiB, WS_GW = 368 * MiB;
constexpr size_t WS_NT = 428 * MiB;
constexpr size_t WS_NTK = 492 * MiB;
constexpr size_t WS_END = 508 * MiB;

template <typename TA> __device__ __forceinline__ float ldA(const TA* p);
template <> __device__ __forceinline__ float ldA<float>(const float* p) { return *p; }
template <> __device__ __forceinline__ float ldA<bf16_t>(const bf16_t* p) { return bf2f(*p); }
template <typename TA>
__global__ void __launch_bounds__(256) ngemm(const TA* __restrict__ A, int lda, const float* __restrict__ B, int ldb, float* __restrict__ C, int ldc, int K) {
    __shared__ float As[16][65];
    __shared__ float Bs[16][65];
    const int tid = threadIdx.x, tx = tid & 15, ty = tid >> 4;
    const int m0 = blockIdx.y * 64, n0 = blockIdx.x * 64;
    float acc[4][4];
#pragma unroll
    for (int i = 0; i < 4; ++i)
#pragma unroll
        for (int j = 0; j < 4; ++j) acc[i][j] = 0.f;
    for (int k0 = 0; k0 < K; k0 += 16) {
#pragma unroll
        for (int i = 0; i < 4; ++i) { const int idx = tid + i * 256; const int r = idx >> 4, c = idx & 15; As[c][r] = ldA<TA>(A + (size_t)(m0 + r) * lda + k0 + c); }
#pragma unroll
        for (int i = 0; i < 4; ++i) { const int idx = tid + i * 256; const int r = idx >> 6, c = idx & 63; Bs[r][c] = B[(size_t)(k0 + r) * ldb + n0 + c]; }
        __syncthreads();
#pragma unroll
        for (int kk = 0; kk < 16; ++kk) {
            float a[4], b[4];
#pragma unroll
            for (int i = 0; i < 4; ++i) { a[i] = As[kk][ty * 4 + i]; b[i] = Bs[kk][tx * 4 + i]; }
#pragma unroll
            for (int i = 0; i < 4; ++i)
#pragma unroll
                for (int j = 0; j < 4; ++j) acc[i][j] = fmaf(a[i], b[j], acc[i][j]);
        }
        __syncthreads();
    }
#pragma unroll
    for (int i = 0; i < 4; ++i)
#pragma unroll
        for (int j = 0; j < 4; ++j) C[(size_t)(m0 + ty * 4 + i) * ldc + n0 + tx * 4 + j] = acc[i][j];
}

__global__ void n_cvt_bf16(const float* __restrict__ src, bf16_t* __restrict__ dst, size_t n) {
    for (size_t i = (size_t)blockIdx.x * blockDim.x + threadIdx.x; i < n; i += (size_t)gridDim.x * blockDim.x) dst[i] = (bf16_t)f2bf(src[i]);
}
__global__ void n_glu(const float* __restrict__ T, bf16_t* __restrict__ hglu) {
    for (size_t i = (size_t)blockIdx.x * blockDim.x + threadIdx.x; i < (size_t)MTOK * CONV_CH; i += (size_t)gridDim.x * blockDim.x) {
        const size_t m = i / CONV_CH, c = i % CONV_CH; hglu[i] = (bf16_t)f2bf(T[m * 2048 + c] * sigmoidf_(T[m * 2048 + 1024 + c])); }
}
__global__ void n_scale_bf16(const float* __restrict__ T, bf16_t* __restrict__ dst, float s, size_t n) {
    for (size_t i = (size_t)blockIdx.x * blockDim.x + threadIdx.x; i < n; i += (size_t)gridDim.x * blockDim.x) dst[i] = (bf16_t)f2bf(T[i] * s);
}
__global__ void n_vt(const float* __restrict__ T, bf16_t* __restrict__ VT) {
    for (size_t i = (size_t)blockIdx.x * blockDim.x + threadIdx.x; i < (size_t)MTOK * 1024; i += (size_t)gridDim.x * blockDim.x) {
        const size_t c = i / MTOK, m = i % MTOK; VT[i] = (bf16_t)f2bf(T[m * 1024 + c]); }
}
__global__ void n_gate(const float* __restrict__ T, const float* __restrict__ bg, bf16_t* __restrict__ Gt, int coff) {
    for (size_t i = (size_t)blockIdx.x * blockDim.x + threadIdx.x; i < (size_t)MTOK * 2048; i += (size_t)gridDim.x * blockDim.x) {
        const size_t m = i / 2048, c = i % 2048; Gt[m * 4096 + coff + c] = (bf16_t)f2bf(sigmoidf_(T[i] + bg[coff + c])); }
}
__global__ void n_dwconv(const bf16_t* __restrict__ hglu, const float* __restrict__ w, const float* __restrict__ b, float* __restrict__ T) {
    for (size_t i = (size_t)blockIdx.x * blockDim.x + threadIdx.x; i < (size_t)MTOK * CONV_CH; i += (size_t)gridDim.x * blockDim.x) {
        const int m = (int)(i / CONV_CH), c = (int)(i % CONV_CH), s = m % SEQ; float acc = b[c];
        for (int j = 0; j < CONV_W; ++j) { const int sp = s - (CONV_W - 1) + j; if (sp >= 0) acc = fmaf(bf2f(hglu[(size_t)(m - (CONV_W - 1) + j) * CONV_CH + c]), w[j * CONV_CH + c], acc); }
        T[i] = acc; }
}
__device__ __forceinline__ float block_sum_256(float v, float* red) {
#pragma unroll
    for (int o = 32; o > 0; o >>= 1) v += __shfl_xor(v, o);
    __syncthreads();
    if ((threadIdx.x & 63) == 0) red[threadIdx.x >> 6] = v;
    __syncthreads();
    return red[0] + red[1] + red[2] + red[3];
}
__global__ void __launch_bounds__(256) n_convln(const float* __restrict__ T, const float* __restrict__ g, const float* __restrict__ b, bf16_t* __restrict__ hc) {
    __shared__ float red[4];
    const int m = blockIdx.x, t = threadIdx.x; float v[4]; float s = 0.f;
#pragma unroll
    for (int i = 0; i < 4; ++i) { v[i] = T[(size_t)m * CONV_CH + t + 256 * i]; s += v[i]; }
    const float mean = block_sum_256(s, red) * (1.f / CONV_CH); float q = 0.f;
#pragma unroll
    for (int i = 0; i < 4; ++i) { v[i] -= mean; q += v[i] * v[i]; }
    const float rstd = rsqrtf(block_sum_256(q, red) * (1.f / CONV_CH) + LN_EPS);
#pragma unroll
    for (int i = 0; i < 4; ++i) { const int c = t + 256 * i; const float y = v[i] * rstd * g[c] + b[c]; hc[(size_t)m * CONV_CH + c] = (bf16_t)f2bf(y * sigmoidf_(y)); }
}
__global__ void n_subln(const float* __restrict__ T, const float* __restrict__ g, bf16_t* __restrict__ on) {
    const int i = blockIdx.x * blockDim.x + threadIdx.x; if (i >= MTOK * AH) return;
    const float* r = T + (size_t)i * 128; float ss = 0.f;
    for (int d = 0; d < 128; ++d) ss += r[d] * r[d];
    const float rs = rsqrtf(ss * (1.f / 128.f) + LN_EPS) * (1.f - LAM_INIT);
    for (int d = 0; d < 128; ++d) on[(size_t)i * 128 + d] = (bf16_t)f2bf(r[d] * rs * g[d]);
}
__global__ void n_mix(const float* __restrict__ T1, const float* __restrict__ T2, const bf16_t* __restrict__ Gt, bf16_t* __restrict__ mixed) {
    for (size_t i = (size_t)blockIdx.x * blockDim.x + threadIdx.x; i < (size_t)MTOK * DM; i += (size_t)gridDim.x * blockDim.x) {
        const size_t m = i / DM, c = i % DM; mixed[i] = (bf16_t)f2bf(bf2f(Gt[m * 4096 + c]) * T1[i] + bf2f(Gt[m * 4096 + 2048 + c]) * T2[i]); }
}
__global__ void __launch_bounds__(256) n_resln(const float* __restrict__ res, const float* __restrict__ add, const float* __restrict__ g, const float* __restrict__ b, float* __restrict__ yf, bf16_t* __restrict__ yb) {
    __shared__ float red[4];
    const int m = blockIdx.x, t = threadIdx.x; float v[8]; float s = 0.f;
#pragma unroll
    for (int i = 0; i < 8; ++i) { const size_t o = (size_t)m * DM + t + 256 * i; v[i] = ALPHA * res[o] + add[o]; s += v[i]; }
    const float mean = block_sum_256(s, red) * (1.f / DM); float q = 0.f;
#pragma unroll
    for (int i = 0; i < 8; ++i) { v[i] -= mean; q += v[i] * v[i]; }
    const float rstd = rsqrtf(block_sum_256(q, red) * (1.f / DM) + LN_EPS);
#pragma unroll
    for (int i = 0; i < 8; ++i) { const int c = t + 256 * i; const float y = v[i] * rstd * g[c] + b[c]; yf[(size_t)m * DM + c] = y; yb[(size_t)m * DM + c] = (bf16_t)f2bf(y); }
}
__global__ void n_scores(const bf16_t* __restrict__ qp, const float* __restrict__ sk, float* __restrict__ S) {
    for (size_t i = (size_t)blockIdx.x * blockDim.x + threadIdx.x; i < (size_t)MTOK * 2048; i += (size_t)gridDim.x * blockDim.x) {
        const size_t m = i / 2048; const int r = (int)(i % 2048), hc = r / 128, n = r % 128; float s = 0.f;
        for (int d = 0; d < 128; ++d) s = fmaf(bf2f(qp[m * 2048 + hc * 128 + d]), bf2f((unsigned)f2bf(sk[((size_t)hc * 128 + n) * 128 + d])), s);
        S[i] = s; }
}
__global__ void n_topk1(const float* __restrict__ S, float* __restrict__ vals, int* __restrict__ idx) {
    const int i = blockIdx.x * blockDim.x + threadIdx.x; if (i >= MTOK * 16) return;
    const float* s = S + (size_t)i * 128; float pv = INFINITY; int pi = -1;
    for (int r = 0; r < 16; ++r) { float bv = -INFINITY; int bi = 0x7fffffff;
        for (int n = 0; n < 128; ++n) { const float v = s[n]; const bool elig = (v < pv) || (v == pv && n > pi); if (elig && (v > bv || (v == bv && n < bi))) { bv = v; bi = n; } }
        vals[(size_t)i * 16 + r] = bv; idx[(size_t)i * 16 + r] = bi; pv = bv; pi = bi; }
}
__global__ void n_topk2(const float* __restrict__ vals, const int* __restrict__ idx, int* __restrict__ ids, float* __restrict__ gw) {
    const int i = blockIdx.x * blockDim.x + threadIdx.x; if (i >= MTOK * 8) return;
    const float* v0 = vals + (size_t)i * 32; const float* v1 = v0 + 16; const int* i0 = idx + (size_t)i * 32; const int* i1 = i0 + 16;
    float best[16]; float pv = INFINITY; int pf = -1;
#pragma unroll
    for (int r = 0; r < 16; ++r) { float bv = -INFINITY; int bf = 0x7fffffff;
        for (int f = 0; f < 256; ++f) { const float v = v0[f >> 4] + v1[f & 15]; const bool elig = (v < pv) || (v == pv && f > pf); if (elig && (v > bv || (v == bv && f < bf))) { bv = v; bf = f; } }
        best[r] = bv; ids[(size_t)i * 16 + r] = i0[bf >> 4] * PNK + i1[bf & 15]; pv = bv; pf = bf; }
    float sum = 0.f; const float bmax = best[0];
#pragma unroll
    for (int r = 0; r < 16; ++r) { best[r] = __expf(best[r] - bmax); sum += best[r]; }
    const float inv = 1.f / sum;
#pragma unroll
    for (int r = 0; r < 16; ++r) gw[(size_t)i * 16 + r] = best[r] * inv;
}
__global__ void __launch_bounds__(256) n_peer(const bf16_t* __restrict__ x1b, const float* __restrict__ x1f, const int* __restrict__ ids, const float* __restrict__ gw,
                                              const float* __restrict__ ut, const float* __restrict__ vt, const float* __restrict__ g, const float* __restrict__ b,
                                              float* __restrict__ x2f, bf16_t* __restrict__ x2b) {
    __shared__ float red[4]; __shared__ float wj[128];
    const int m = blockIdx.x, t = threadIdx.x; float xr[8];
#pragma unroll
    for (int i = 0; i < 8; ++i) xr[i] = bf2f(x1b[(size_t)m * DM + t + 256 * i]);
    for (int j = 0; j < 128; ++j) { const float* u = ut + (size_t)ids[(size_t)m * 128 + j] * DM; float s = 0.f;
#pragma unroll
        for (int i = 0; i < 8; ++i) s = fmaf(xr[i], u[t + 256 * i], s);
        const float hsum = block_sum_256(s, red);
        if (t == 0) wj[j] = gw[(size_t)m * 128 + j] * gelu_tanh(hsum); }
    __syncthreads();
    float o[8];
#pragma unroll
    for (int i = 0; i < 8; ++i) o[i] = 0.f;
    for (int j = 0; j < 128; ++j) { const float* v = vt + (size_t)ids[(size_t)m * 128 + j] * DM; const float w = wj[j];
#pragma unroll
        for (int i = 0; i < 8; ++i) o[i] = fmaf(w, v[t + 256 * i], o[i]); }
    float s = 0.f;
#pragma unroll
    for (int i = 0; i < 8; ++i) { o[i] += ALPHA * x1f[(size_t)m * DM + t + 256 * i]; s += o[i]; }
    const float mean = block_sum_256(s, red) * (1.f / DM); float q = 0.f;
#pragma unroll
    for (int i = 0; i < 8; ++i) { o[i] -= mean; q += o[i] * o[i]; }
    const float rstd = rsqrtf(block_sum_256(q, red) * (1.f / DM) + LN_EPS);
#pragma unroll
    for (int i = 0; i < 8; ++i) { const int c = t + 256 * i; const float y = o[i] * rstd * g[c] + b[c]; x2f[(size_t)m * DM + c] = y; x2b[(size_t)m * DM + c] = (bf16_t)f2bf(y); }
}
__global__ void n_final(const float* __restrict__ x2f, const float* __restrict__ T, const float* __restrict__ bg, const float* __restrict__ E, float* __restrict__ out) {
    for (size_t i = (size_t)blockIdx.x * blockDim.x + threadIdx.x; i < (size_t)MTOK * DM; i += (size_t)gridDim.x * blockDim.x) {
        const size_t c = i % DM; out[i] = x2f[i] + sigmoidf_(T[i] + bg[c]) * E[i]; }
}
__global__ void n_lambda(const float* q1, const float* k1, const float* q2, const float* k2, float* lam) {
    if (threadIdx.x == 0 && blockIdx.x == 0) { float a = 0.f, b = 0.f; for (int i = 0; i < 64; ++i) { a += q1[i] * k1[i]; b += q2[i] * k2[i]; } lam[0] = expf(a) - expf(b) + LAM_INIT; }
}

enum { I_X = 0, I_P, I_WIN, I_BGATE, I_DWW, I_DWB, I_CLNG, I_CLNB, I_CWOUT, I_LQ1, I_LK1, I_LQ2, I_LK2, I_SUBLN, I_AWO, I_WOUT, I_LN1G, I_LN1B, I_PWQ, I_PSK, I_PU, I_PV, I_LN2G, I_LN2B, I_PLEWP, I_PLEWG, I_PLEBG, N_IN };
__global__ void __launch_bounds__(64) n_attn2(const bf16_t* __restrict__ Qb, const bf16_t* __restrict__ Kb, const bf16_t* __restrict__ VT, const float* __restrict__ lamp, float* __restrict__ T) {
    const float lam = lamp[0];
    const int q = blockIdx.x * 64 + threadIdx.x, chunk = blockIdx.y, bh = blockIdx.z, b = bh / AH, h = bh % AH;
    const float slope2 = exp2f(-(float)(h + 1)) * LOG2E;
    const size_t rowq = (size_t)b * SEQ + q;
    float res[32];
#pragma unroll
    for (int d = 0; d < 32; ++d) res[d] = 0.f;
    const int kmax = blockIdx.x * 64 + 63;
    for (int map = 0; map < 2; ++map) {
        float qv[64];
#pragma unroll
        for (int d = 0; d < 64; ++d) qv[d] = bf2f(Qb[rowq * 1024 + h * 128 + map * 64 + d]);
        float o[32];
#pragma unroll
        for (int d = 0; d < 32; ++d) o[d] = 0.f;
        float mx = -INFINITY, l = 0.f;
        for (int k = 0; k <= kmax; ++k) {
            const bf16_t* kr = Kb + ((size_t)b * SEQ + k) * 1024 + h * 128 + map * 64; float s = 0.f;
#pragma unroll
            for (int d = 0; d < 64; ++d) s = fmaf(qv[d], bf2f(kr[d]), s);
            s -= slope2 * (float)(q - k);
            if (k <= q) {
                const float mn = fmaxf(mx, s), c = exp2f(mx - mn), p = exp2f(s - mn); l = l * c + p; mx = mn;
#pragma unroll
                for (int d = 0; d < 32; ++d) o[d] = o[d] * c + p * bf2f(VT[(size_t)(h * 128 + chunk * 32 + d) * MTOK + (size_t)b * SEQ + k]);
            }
        }
        const float il = 1.f / l, sg = map == 0 ? 1.f : -lam;
#pragma unroll
        for (int d = 0; d < 32; ++d) res[d] += sg * o[d] * il;
    }
#pragma unroll
    for (int d = 0; d < 32; ++d) T[rowq * 1024 + h * 128 + chunk * 32 + d] = res[d];
}

#ifndef P8_NSPLIT
#define P8_NSPLIT 4
#endif
#define GAS __attribute__((address_space(1)))
#define LAS __attribute__((address_space(3)))
typedef short bf16x8 __attribute__((ext_vector_type(8)));
typedef float f32x4 __attribute__((ext_vector_type(4)));
typedef float f32x2 __attribute__((ext_vector_type(2)));
typedef float f32x16 __attribute__((ext_vector_type(16)));
typedef unsigned u32x4 __attribute__((ext_vector_type(4)));
typedef unsigned u32x2 __attribute__((ext_vector_type(2)));
typedef __bf16 bf16x2_t __attribute__((ext_vector_type(2)));
typedef GAS unsigned gu32;
#define RLX_AGENT __ATOMIC_RELAXED, __HIP_MEMORY_SCOPE_AGENT
#define LDS_WAIT() asm volatile("s_waitcnt lgkmcnt(0)" ::: "memory")
#define VM_WAIT() asm volatile("s_waitcnt vmcnt(0)" ::: "memory")
constexpr int NWAVES = 8, NTHREADS = 512;
constexpr int RING_BYTES = 131072;
constexpr int XTRA_OFF = RING_BYTES;
constexpr int MISC_OFF = 161792;
constexpr int LDS_BYTES = 163840;

__device__ __forceinline__ unsigned pk2(float lo, float hi) { f32x2 v = {lo, hi}; bf16x2_t b = __builtin_convertvector(v, bf16x2_t); return __builtin_bit_cast(unsigned, b); }
__device__ __forceinline__ float bflo(unsigned w) { return __builtin_bit_cast(float, w << 16); }
__device__ __forceinline__ float bfhi(unsigned w) { return __builtin_bit_cast(float, w & 0xffff0000u); }
__device__ __forceinline__ float fsigmoid(float v) { return __builtin_amdgcn_rcpf(1.0f + __builtin_amdgcn_exp2f(-LOG2E * v)); }

#define XB_TMO      128
#define XB_XCNT(j)  (256  + 64 * (j))
#define XB_XSUB(j)  (1280 + 64 * (j))
#define XB_XGEN(j)  (2304 + 64 * (j))
#define XB_TOP      3328
#define XB_TOPGEN   3392
#define XCD_BAR_WORDS 3456
#define XB_SPIN_CAP (1u << 22)
__device__ __forceinline__ unsigned xb_ld(unsigned* p)              { return __hip_atomic_load(p, __ATOMIC_RELAXED, __HIP_MEMORY_SCOPE_AGENT); }
__device__ __forceinline__ unsigned xb_add(unsigned* p, unsigned v) { return __hip_atomic_fetch_add(p, v, __ATOMIC_RELAXED, __HIP_MEMORY_SCOPE_AGENT); }
__device__ __forceinline__ unsigned xb_xcc_id() { return (unsigned)__builtin_amdgcn_s_getreg((3 << 11) | 20) & 0xFu; }
#define XB_SPIN(cond, bar) do { unsigned _sp = 0; while (cond) { __builtin_amdgcn_s_sleep(1); \
    if ((++_sp & 255u) == 0u) { if (xb_ld(&(bar)[XB_TMO])) break; if (_sp > XB_SPIN_CAP) { atomicAdd(&(bar)[XB_TMO], 1u); break; } } } } while (0)
struct XcdBarrier { unsigned* bar; unsigned x; volatile LAS unsigned* st; };
__device__ __forceinline__ XcdBarrier xcd_barrier_post(unsigned* bar, volatile LAS unsigned* st) {
    XcdBarrier b; b.bar = bar; b.x = xb_xcc_id(); b.st = st;
    if (threadIdx.x == 0) (void)xb_add(&bar[XB_XCNT(b.x)], 1u);
    return b;
}
__device__ __forceinline__ void xcd_barrier_complete(unsigned* bar, unsigned x, unsigned& nloc, unsigned& nx) {
    const unsigned G = gridDim.x * gridDim.y * gridDim.z;
    unsigned sum, cnt, mine, sp = 0u;
    for (;;) {
        sum = 0u; cnt = 0u; mine = 0u;
#pragma unroll
        for (unsigned j = 0; j < 16; ++j) { const unsigned c = xb_ld(&bar[XB_XCNT(j)]); sum += c; cnt += (c > 0u) ? 1u : 0u; mine = (j == x) ? c : mine; }
        if (sum == G) break;
        __builtin_amdgcn_s_sleep(1);
        if ((++sp & 255u) == 0u) { if (xb_ld(&bar[XB_TMO])) break; if (sp > XB_SPIN_CAP) { atomicAdd(&bar[XB_TMO], 1u); break; } }
    }
    nloc = mine > 0u ? mine : 1u; nx = cnt > 0u ? cnt : 1u;
}
__device__ __forceinline__ void xcd_barrier(const XcdBarrier& b) {
    asm volatile("s_waitcnt vmcnt(0)" ::: "memory");
    __syncthreads();
    if (threadIdx.x == 0) {
        unsigned* bar = b.bar;
        __builtin_amdgcn_s_waitcnt(0);
        unsigned nloc = b.st[0], nx = b.st[1];
        if (nloc == 0u) { xcd_barrier_complete(bar, b.x, nloc, nx); b.st[0] = nloc; b.st[1] = nx; }
        const unsigned old = xb_add(&bar[XB_XSUB(b.x)], 1u);
        const unsigned gen = old / nloc;
        if (old + 1u == (gen + 1u) * nloc) {
            __builtin_amdgcn_fence(__ATOMIC_RELEASE, "agent");
            asm volatile("s_waitcnt vmcnt(0)" ::: "memory");
            const unsigned og = xb_add(&bar[XB_TOP], 1u);
            const unsigned tg = og / nx;
            if (og + 1u == (tg + 1u) * nx) xb_add(&bar[XB_TOPGEN], 1u);
            else XB_SPIN(xb_ld(&bar[XB_TOPGEN]) == tg, bar);
            __builtin_amdgcn_fence(__ATOMIC_ACQUIRE, "agent");
            xb_add(&bar[XB_XGEN(b.x)], 1u);
            asm volatile("s_waitcnt vmcnt(0)" ::: "memory");
        } else {
            XB_SPIN(xb_ld(&bar[XB_XGEN(b.x)]) == gen, bar);
            __builtin_amdgcn_fence(__ATOMIC_ACQUIRE, "agent");
            asm volatile("s_waitcnt vmcnt(0)" ::: "memory");
        }
    }
    __syncthreads();
}

namespace pg8 {
constexpr int BM = 256, BK = 64, HALF = 128, HTB = HALF * BK * 2, STAGE_BYTES = 8 * HTB, NXCD = 8, WGM = 8;
__host__ __device__ __forceinline__ int lds_byte(int r, int c) { const int st = (r >> 4) * 2 + (c >> 5), rr = r & 15, cc = c & 31, ob = rr * 64 + cc * 2; return st * 1024 + (ob ^ (((ob >> 9) & 1) << 5)); }
__host__ __device__ __forceinline__ void stage_rc(int b, int& R, int& C) { const int st = b / 1024, sb = b % 1024, swz = sb ^ (((sb >> 9) & 1) << 5); R = (st >> 1) * 16 + swz / 64; C = (st & 1) * 32 + (swz % 64) / 2; }
__host__ __device__ __forceinline__ int perm32(int rho) { const int n = rho >> 4, i = rho & 15; return 8 * (i >> 2) + 4 * n + (i & 3); }
struct Unit { int pm, pn; };
struct Gemm { const bf16_t* A; const bf16_t* Bt; int lda, ldb, K; };
struct StaticOrder {
    int nM, nN, nwg, G, c;
    __host__ __device__ void init(int M, int N, int G_, int c_) { nM = M / BM; nN = N / BM; nwg = nM * nN; G = G_; c = c_; }
    __host__ __device__ bool next(int i, Unit& u) const {
        const long L = (long)i * G + c; if (L >= nwg) return false;
        int wgid = (int)L; { const int q = nwg / NXCD, r = nwg % NXCD, xcd = wgid % NXCD, off = wgid / NXCD; wgid = (xcd < r ? xcd * (q + 1) : r * (q + 1) + (xcd - r) * q) + off; }
        const int nig = WGM * nN, gid = wgid / nig, fm = gid * WGM, gsz = (nM - fm) < WGM ? (nM - fm) : WGM;
        u.pm = fm + ((wgid % nig) % gsz); u.pn = (wgid % nig) / gsz; return true;
    }
};
template <class Epi, bool SP2 = true>
__device__ __forceinline__ void gemm_phase(LAS unsigned char* lds, const Gemm g, const StaticOrder& S, const Epi& E) {
    int tid_ = threadIdx.x; asm volatile("" : "+v"(tid_));
    const int tid = tid_, wid = __builtin_amdgcn_readfirstlane(tid >> 6), lane = tid & 63, wr = wid >> 2, wc = wid & 3, fr = lane & 15, fq = lane >> 4;
    const int K = g.K, nt = K / BK;
    unsigned voffA[2], voffB[2];
#pragma unroll
    for (int i = 0; i < 2; ++i) { int R, C; stage_rc(tid * 16 + i * 8192, R, C); const int Rb = Epi::PERM ? ((R & ~31) + perm32(R & 31)) : R;
        voffA[i] = (unsigned)(R * g.lda + C) * 2u; voffB[i] = (unsigned)(Rb * g.ldb + C) * 2u; }
    const size_t kstep = (size_t)(BK * 2);
    const size_t hstepA = (size_t)HALF * g.lda * 2, hstepB = (size_t)HALF * g.ldb * 2;
    const size_t tstepA = 2 * hstepA, tstepB = 2 * hstepB;
    const unsigned ldsw = (unsigned)wid * 1024u;
    const int aoff = lds_byte(wr * 64 + fr, fq * 8), boff = lds_byte(wc * 32 + fr, fq * 8);
#define PG8_SA(b, h) (((b) * 2 + (h)) * HTB)
#define PG8_SB(b, h) ((4 + (b) * 2 + (h)) * HTB)
#define PG8_STAGE(bufoff, gbase, voff) do { _Pragma("unroll") for (int _i = 0; _i < 2; ++_i) \
        __builtin_amdgcn_global_load_lds((const unsigned*)((const char*)(gbase) + (voff)[_i]), (LAS unsigned*)(lds + (bufoff) + ldsw + _i * 8192), 16, 0, 0); } while (0)
#define PG8_LDA(dst, b, h) do { _Pragma("unroll") for (int m = 0; m < 4; ++m) _Pragma("unroll") for (int k = 0; k < 2; ++k) dst[m][k] = *(const LAS bf16x8*)(lds + PG8_SA(b, h) + aoff + m * 2048 + k * 1024); } while (0)
#define PG8_LDB(dst, b, h) do { _Pragma("unroll") for (int n = 0; n < 2; ++n) _Pragma("unroll") for (int k = 0; k < 2; ++k) dst[n][k] = *(const LAS bf16x8*)(lds + PG8_SB(b, h) + boff + n * 2048 + k * 1024); } while (0)
#define PG8_MMA(ai, bj, At, Bt) do { __builtin_amdgcn_s_setprio(1); _Pragma("unroll") for (int m = 0; m < 4; ++m) _Pragma("unroll") for (int n = 0; n < 2; ++n) _Pragma("unroll") for (int k = 0; k < 2; ++k) \
        acc[ai][bj][m][n] = __builtin_amdgcn_mfma_f32_16x16x32_bf16(Bt[n][k], At[m][k], acc[ai][bj][m][n], 0, 0, 0); __builtin_amdgcn_s_setprio(0); } while (0)
#define PG8_WAIT_V(n) asm volatile("s_waitcnt vmcnt(" #n ")" ::: "memory")
#define PG8_WAIT_L(n) asm volatile("s_waitcnt lgkmcnt(" #n ")" ::: "memory")
#define PG8_BAR __builtin_amdgcn_s_barrier()
#define PG8_SCHED __builtin_amdgcn_sched_barrier(0)
    Unit cur, nxt; int ui = 0;
    if (!S.next(0, cur)) return;
    f32x4 acc[2][2][4][2];
#pragma unroll
    for (int a = 0; a < 2; ++a)
#pragma unroll
        for (int b = 0; b < 2; ++b)
#pragma unroll
            for (int m = 0; m < 4; ++m)
#pragma unroll
                for (int n = 0; n < 2; ++n) acc[a][b][m][n] = (f32x4){0.f, 0.f, 0.f, 0.f};
    bf16x8 At[4][2], B0[2][2], B1[2][2];
    const char* cA = (const char*)g.A + (size_t)cur.pm * tstepA; const char* cB = (const char*)g.Bt + (size_t)cur.pn * tstepB;
    if constexpr (SP2) {
        PG8_STAGE(PG8_SB(0, 0), cB, voffB); PG8_STAGE(PG8_SB(0, 1), cB + hstepB, voffB); PG8_STAGE(PG8_SA(0, 0), cA, voffA); PG8_STAGE(PG8_SA(0, 1), cA + hstepA, voffA);
        if (wr == 1) PG8_BAR;
        PG8_WAIT_V(2); PG8_BAR;
        PG8_STAGE(PG8_SB(1, 0), cB + kstep, voffB); PG8_STAGE(PG8_SA(1, 0), cA + kstep, voffA); PG8_STAGE(PG8_SB(1, 1), cB + hstepB + kstep, voffB);
        PG8_WAIT_V(6); PG8_BAR;
    } else {
        PG8_STAGE(PG8_SB(0, 0), cB, voffB); PG8_STAGE(PG8_SA(0, 0), cA, voffA); PG8_STAGE(PG8_SB(0, 1), cB + hstepB, voffB); PG8_STAGE(PG8_SA(0, 1), cA + hstepA, voffA);
        if (wr == 1) PG8_BAR;
        PG8_WAIT_V(4); PG8_BAR;
        PG8_STAGE(PG8_SB(1, 0), cB + kstep, voffB); PG8_STAGE(PG8_SA(1, 0), cA + kstep, voffA); PG8_STAGE(PG8_SB(1, 1), cB + hstepB + kstep, voffB);
        PG8_WAIT_V(6); PG8_BAR;
    }
    for (;;) {
        const bool has_next = S.next(ui + 1, nxt);
        const char* nA = has_next ? (const char*)g.A + (size_t)nxt.pm * tstepA : cA; const char* nB = has_next ? (const char*)g.Bt + (size_t)nxt.pn * tstepB : cB;
        for (int t = 0; t < nt; t += 2) {
            const bool last = (t == nt - 2);
            const char* a1 = cA + (size_t)(t + 1) * kstep;
            const char* a2 = last ? nA : cA + (size_t)(t + 2) * kstep; const char* b2 = last ? nB : cB + (size_t)(t + 2) * kstep;
            const char* a3 = a2 + kstep; const char* b3 = b2 + kstep;
            if constexpr (SP2) {
            PG8_LDB(B0, 0, 0); PG8_LDB(B1, 0, 1); PG8_SCHED; PG8_LDA(At, 0, 0); PG8_STAGE(PG8_SA(1, 1), a1 + hstepA, voffA);
            PG8_WAIT_V(8); PG8_WAIT_L(0); PG8_BAR; PG8_MMA(0, 0, At, B0); PG8_MMA(0, 1, At, B1); PG8_BAR; PG8_SCHED;
            PG8_LDA(At, 0, 1); PG8_STAGE(PG8_SB(0, 0), b2, voffB); PG8_STAGE(PG8_SB(0, 1), b2 + hstepB, voffB); PG8_STAGE(PG8_SA(0, 0), a2, voffA);
            PG8_WAIT_V(8); PG8_WAIT_L(0); PG8_BAR; PG8_MMA(1, 0, At, B0); PG8_MMA(1, 1, At, B1); PG8_BAR; PG8_SCHED;
            PG8_LDB(B0, 1, 0); PG8_LDB(B1, 1, 1); PG8_SCHED; PG8_LDA(At, 1, 0); PG8_STAGE(PG8_SA(0, 1), a2 + hstepA, voffA);
            PG8_WAIT_V(8); PG8_WAIT_L(0); PG8_BAR; PG8_MMA(0, 0, At, B0); PG8_MMA(0, 1, At, B1); PG8_BAR; PG8_SCHED;
            PG8_LDA(At, 1, 1); PG8_STAGE(PG8_SB(1, 0), b3, voffB); PG8_STAGE(PG8_SB(1, 1), b3 + hstepB, voffB); PG8_STAGE(PG8_SA(1, 0), a3, voffA);
            PG8_WAIT_V(8); PG8_WAIT_L(0); PG8_BAR; PG8_MMA(1, 0, At, B0); PG8_MMA(1, 1, At, B1); PG8_BAR; PG8_SCHED;
            } else {
            PG8_LDB(B0, 0, 0); PG8_SCHED; PG8_LDA(At, 0, 0); PG8_STAGE(PG8_SA(1, 1), a1 + hstepA, voffA);
            PG8_WAIT_L(8); PG8_BAR; PG8_WAIT_L(0); PG8_MMA(0, 0, At, B0); PG8_BAR; PG8_SCHED;
            PG8_LDB(B1, 0, 1); PG8_STAGE(PG8_SB(0, 0), b2, voffB);
            PG8_BAR; PG8_WAIT_L(0); PG8_MMA(0, 1, At, B1); PG8_BAR;
            PG8_LDA(At, 0, 1); PG8_STAGE(PG8_SA(0, 0), a2, voffA);
            PG8_BAR; PG8_WAIT_L(0); PG8_MMA(1, 0, At, B0); PG8_BAR; PG8_SCHED;
            PG8_STAGE(PG8_SB(0, 1), b2 + hstepB, voffB);
            PG8_WAIT_V(6); PG8_BAR; PG8_MMA(1, 1, At, B1); PG8_BAR;
            PG8_LDB(B0, 1, 0); PG8_SCHED; PG8_LDA(At, 1, 0); PG8_STAGE(PG8_SA(0, 1), a2 + hstepA, voffA);
            PG8_WAIT_L(8); PG8_BAR; PG8_WAIT_L(0); PG8_MMA(0, 0, At, B0); PG8_BAR; PG8_SCHED;
            PG8_LDB(B1, 1, 1); PG8_STAGE(PG8_SB(1, 0), b3, voffB);
            PG8_BAR; PG8_WAIT_L(0); PG8_MMA(0, 1, At, B1); PG8_BAR;
            PG8_LDA(At, 1, 1); PG8_STAGE(PG8_SA(1, 0), a3, voffA);
            PG8_BAR; PG8_WAIT_L(0); PG8_MMA(1, 0, At, B0); PG8_BAR; PG8_SCHED;
            PG8_STAGE(PG8_SB(1, 1), b3 + hstepB, voffB);
            PG8_WAIT_V(6); PG8_BAR; PG8_MMA(1, 1, At, B1); PG8_BAR;
            }
        }
        if (wr == 0) PG8_BAR;
        E(acc, cur, wr, wc, fr, fq);
        if (!has_next) break;
#pragma unroll
        for (int a = 0; a < 2; ++a)
#pragma unroll
            for (int b = 0; b < 2; ++b)
#pragma unroll
                for (int m = 0; m < 4; ++m)
#pragma unroll
                    for (int n = 0; n < 2; ++n) acc[a][b][m][n] = (f32x4){0.f, 0.f, 0.f, 0.f};
        cur = nxt; cA = nA; cB = nB; ++ui;
        if (wr == 1) PG8_BAR;
    }
    PG8_WAIT_V(0);
    PG8_BAR;
#undef PG8_SA
#undef PG8_SB
#undef PG8_STAGE
#undef PG8_LDA
#undef PG8_LDB
#undef PG8_MMA
#undef PG8_WAIT_V
#undef PG8_WAIT_L
#undef PG8_BAR
#undef PG8_SCHED
}
}

typedef f32x4 Acc[2][2][4][2];
struct EpiP1 {
    static constexpr bool PERM = true;
    bf16_t *hglu, *Qb, *Kb, *Gt; const float* bgate;
    __device__ __forceinline__ void operator()(const Acc& acc, const pg8::Unit& u, int wr, int wc, int fr, int fq) const {
        const int row0 = u.pm * 256 + wr * 64 + fr, pn = u.pn;
        if (pn < 8) {
            const int col0 = pn * 128 + wc * 32 + 8 * fq;
#pragma unroll
            for (int ai = 0; ai < 2; ++ai)
#pragma unroll
                for (int m = 0; m < 4; ++m) { const f32x4 a0 = acc[ai][0][m][0], a1 = acc[ai][0][m][1], g0 = acc[ai][1][m][0], g1 = acc[ai][1][m][1]; u32x4 w;
                    w.x = pk2(a0[0] * fsigmoid(g0[0]), a0[1] * fsigmoid(g0[1])); w.y = pk2(a0[2] * fsigmoid(g0[2]), a0[3] * fsigmoid(g0[3]));
                    w.z = pk2(a1[0] * fsigmoid(g1[0]), a1[1] * fsigmoid(g1[1])); w.w = pk2(a1[2] * fsigmoid(g1[2]), a1[3] * fsigmoid(g1[3]));
                    *(u32x4*)(hglu + (size_t)(row0 + ai * 128 + m * 16) * CONV_CH + col0) = w; }
        } else if (pn < 16) {
            bf16_t* dst = pn < 12 ? Qb : Kb; const float sc = pn < 12 ? QSCALE : 1.0f; const int col0 = (pn & 3) * 256 + wc * 32 + 8 * fq;
#pragma unroll
            for (int ai = 0; ai < 2; ++ai)
#pragma unroll
                for (int m = 0; m < 4; ++m)
#pragma unroll
                    for (int bj = 0; bj < 2; ++bj) { const f32x4 v0 = acc[ai][bj][m][0] * sc, v1 = acc[ai][bj][m][1] * sc; u32x4 w;
                        w.x = pk2(v0[0], v0[1]); w.y = pk2(v0[2], v0[3]); w.z = pk2(v1[0], v1[1]); w.w = pk2(v1[2], v1[3]);
                        *(u32x4*)(dst + (size_t)(row0 + ai * 128 + m * 16) * 1024 + col0 + bj * 128) = w; }
        } else {
            const int col0 = (pn - 16) * 256 + wc * 32 + 8 * fq;
#pragma unroll
            for (int bj = 0; bj < 2; ++bj) { const f32x4 b0 = *(const f32x4*)(bgate + col0 + bj * 128), b1 = *(const f32x4*)(bgate + col0 + bj * 128 + 4);
#pragma unroll
                for (int ai = 0; ai < 2; ++ai)
#pragma unroll
                    for (int m = 0; m < 4; ++m) { const f32x4 v0 = acc[ai][bj][m][0] + b0, v1 = acc[ai][bj][m][1] + b1; u32x4 w;
                        w.x = pk2(fsigmoid(v0[0]), fsigmoid(v0[1])); w.y = pk2(fsigmoid(v0[2]), fsigmoid(v0[3])); w.z = pk2(fsigmoid(v1[0]), fsigmoid(v1[1])); w.w = pk2(fsigmoid(v1[2]), fsigmoid(v1[3]));
                        *(u32x4*)(Gt + (size_t)(row0 + ai * 128 + m * 16) * 4096 + col0 + bj * 128) = w; } }
        }
    }
};
struct EpiBf16 {
    static constexpr bool PERM = true;
    bf16_t* O; int ldc;
    __device__ __forceinline__ void operator()(const Acc& acc, const pg8::Unit& u, int wr, int wc, int fr, int fq) const {
        const int row0 = u.pm * 256 + wr * 64 + fr, col0 = u.pn * 256 + wc * 32 + 8 * fq;
#pragma unroll
        for (int ai = 0; ai < 2; ++ai)
#pragma unroll
            for (int m = 0; m < 4; ++m)
#pragma unroll
                for (int bj = 0; bj < 2; ++bj) { const f32x4 v0 = acc[ai][bj][m][0], v1 = acc[ai][bj][m][1]; u32x4 w;
                    w.x = pk2(v0[0], v0[1]); w.y = pk2(v0[2], v0[3]); w.z = pk2(v1[0], v1[1]); w.w = pk2(v1[2], v1[3]);
                    *(u32x4*)(O + (size_t)(row0 + ai * 128 + m * 16) * ldc + col0 + bj * 128) = w; }
    }
};
template <int MODE> struct EpiF32 {
    static constexpr bool PERM = false;
    float* T1; const bf16_t* G; bf16_t* OB; const float* X; float* OUT; const float* bias;
    __device__ __forceinline__ void operator()(const Acc& acc, const pg8::Unit& u, int wr, int wc, int fr, int fq) const {
        const int row0 = u.pm * 256 + wr * 64 + fr, col0 = u.pn * 256 + wc * 32 + 4 * fq;
#pragma unroll
        for (int ai = 0; ai < 2; ++ai)
#pragma unroll
            for (int m = 0; m < 4; ++m) { const size_t row = (size_t)(row0 + ai * 128 + m * 16);
#pragma unroll
                for (int bj = 0; bj < 2; ++bj)
#pragma unroll
                    for (int n = 0; n < 2; ++n) { const int col = col0 + bj * 128 + n * 16; const f32x4 a = acc[ai][bj][m][n]; const size_t o = row * DM + col;
                        if constexpr (MODE == 0) { const u32x2 gw_ = *(const u32x2*)(G + row * 4096 + col); *(f32x4*)(T1 + o) = (f32x4){a[0] * bflo(gw_.x), a[1] * bfhi(gw_.x), a[2] * bflo(gw_.y), a[3] * bfhi(gw_.y)}; }
                        if constexpr (MODE == 1) { const u32x2 gw_ = *(const u32x2*)(G + row * 4096 + 2048 + col); const f32x4 t = *(const f32x4*)(T1 + o);
                            u32x2 w; w.x = pk2(t[0] + a[0] * bflo(gw_.x), t[1] + a[1] * bfhi(gw_.x)); w.y = pk2(t[2] + a[2] * bflo(gw_.y), t[3] + a[3] * bfhi(gw_.y)); *(u32x2*)(OB + o) = w; }
                        if constexpr (MODE == 2) { const f32x4 x = *(const f32x4*)(X + o); *(f32x4*)(OUT + o) = x * ALPHA + a; }
                        if constexpr (MODE == 3) { *(f32x4*)(T1 + o) = a; }
                        if constexpr (MODE == 4) { const f32x4 x = *(const f32x4*)(X + o), e = *(const f32x4*)(T1 + o), b = *(const f32x4*)(bias + col);
                            *(f32x4*)(OUT + o) = (f32x4){x[0] + fsigmoid(a[0] + b[0]) * e[0], x[1] + fsigmoid(a[1] + b[1]) * e[1], x[2] + fsigmoid(a[2] + b[2]) * e[2], x[3] + fsigmoid(a[3] + b[3]) * e[3]}; }
                    } }
    }
};

struct Args { const float* in[N_IN]; float* out; unsigned char* ws; int ph_lo, ph_hi; };
struct Frame { LAS unsigned char* lds; int tid, lane, wave, vcu, G; const float* const* in; unsigned char* ws; float* out; };
__device__ __forceinline__ float wave_sum(float v) {
#pragma unroll
    for (int o = 1; o < 64; o <<= 1) v += __shfl_xor(v, o);
    return v;
}
__device__ __forceinline__ void p0_transpose_item(const float* W, int K, int N, bf16_t* WT, int dst_row0, int k0, int n0, LAS float* scr, int lane) {
#pragma unroll 8
    for (int i = 0; i < 32; ++i) { const int kk = 2 * i + (lane >> 5); scr[kk * 33 + (lane & 31)] = W[(size_t)(k0 + kk) * N + n0 + (lane & 31)]; }
    LDS_WAIT(); asm volatile("" ::: "memory");
    const int c = lane & 7;
#pragma unroll
    for (int j = 0; j < 4; ++j) { const int n = (lane >> 3) + 8 * j; const LAS float* s = scr + (8 * c) * 33 + n;
        u32x4 o; o.x = pk2(s[0 * 33], s[1 * 33]); o.y = pk2(s[2 * 33], s[3 * 33]); o.z = pk2(s[4 * 33], s[5 * 33]); o.w = pk2(s[6 * 33], s[7 * 33]);
        *(GAS u32x4*)(WT + (size_t)(dst_row0 + n) * K + k0 + 8 * c) = o; }
    LDS_WAIT(); asm volatile("" ::: "memory");
}
__device__ __forceinline__ int win_dst_row(int col) {
    if (col < 1024) return (col >> 7) * 256 + (col & 127);
    if (col < 2048) return ((col - 1024) >> 7) * 256 + 128 + (col & 127);
    if (col < 4096) return col;
    if (col < 5120) return col + 4096;
    return col - 1024;
}
__device__ __forceinline__ void p0_transpose_matrix(Frame& F, const float* W, int K, int N, bf16_t* WT, bool is_win, int& it0, LAS float* scr) {
    const int gw = F.vcu * NWAVES + F.wave, NGW = F.G * NWAVES, nblk = N / 32, nitems = (K / 64) * nblk;
    int first = gw - (it0 % NGW); if (first < 0) first += NGW;
    for (int r = first; r < nitems; r += NGW) { const int kb = r / nblk, nb = r % nblk, n0 = 32 * nb; p0_transpose_item(W, K, N, WT, is_win ? win_dst_row(n0) : n0, 64 * kb, n0, scr, F.lane); }
    it0 += nitems;
}
__device__ __forceinline__ void p0_cvt(Frame& F, const float* src, bf16_t* dst, size_t n) {
    const size_t gt = (size_t)F.vcu * NTHREADS + F.tid, NGT = (size_t)F.G * NTHREADS;
    for (size_t i = gt * 8; i < n; i += NGT * 8) { const f32x4 a = *(const GAS f32x4*)(src + i), b = *(const GAS f32x4*)(src + i + 4);
        u32x4 w; w.x = pk2(a[0], a[1]); w.y = pk2(a[2], a[3]); w.z = pk2(b[0], b[1]); w.w = pk2(b[2], b[3]); *(GAS u32x4*)(dst + i) = w; }
}
__device__ __forceinline__ void p0_row_fp8(const float* src, unsigned char* tab, int e, float* inv, int lane) {
    f32x4 v[8]; float am = 0.f;
#pragma unroll
    for (int j = 0; j < 8; ++j) { v[j] = ((const GAS f32x4*)src)[lane + 64 * j]; am = fmaxf(fmaxf(am, fmaxf(fabsf(v[j].x), fabsf(v[j].y))), fmaxf(fabsf(v[j].z), fabsf(v[j].w))); }
#pragma unroll
    for (int o = 1; o < 64; o <<= 1) am = fmaxf(am, __shfl_xor(am, o));
    const float sc = am > 0.f ? 256.0f / am : 1.0f;
#pragma unroll
    for (int j = 0; j < 8; ++j) { int p = 0; p = __builtin_amdgcn_cvt_pk_fp8_f32(v[j].x * sc, v[j].y * sc, p, false); p = __builtin_amdgcn_cvt_pk_fp8_f32(v[j].z * sc, v[j].w * sc, p, true);
        const int b = 4 * (lane + 64 * j), q = b / (DM / P8_NSPLIT), within = b % (DM / P8_NSPLIT);
        *(GAS unsigned*)(tab + ((size_t)q * NEXP + e) * (DM / P8_NSPLIT) + within) = (unsigned)p; }
    if (lane == 0) *inv = am > 0.f ? am * (1.0f / 256.0f) : 1.0f;
}
__device__ __forceinline__ void p0_prologue(Frame& F) {
    LAS float* scr = (LAS float*)(F.lds + F.wave * 16384);
    int it0 = 0;
    p0_transpose_matrix(F, F.in[I_WIN], DM, IN_COLS, (bf16_t*)(F.ws + WS_WINT), true, it0, scr);
    p0_transpose_matrix(F, F.in[I_CWOUT], CONV_CH, DM, (bf16_t*)(F.ws + WS_WCT), false, it0, scr);
    p0_transpose_matrix(F, F.in[I_AWO], 1024, DM, (bf16_t*)(F.ws + WS_WOT), false, it0, scr);
    p0_transpose_matrix(F, F.in[I_WOUT], DM, DM, (bf16_t*)(F.ws + WS_WOUTT), false, it0, scr);
    p0_transpose_matrix(F, F.in[I_PWQ], DM, DM, (bf16_t*)(F.ws + WS_WQT), false, it0, scr);
    p0_transpose_matrix(F, F.in[I_PLEWG], DM, DM, (bf16_t*)(F.ws + WS_WPGT), false, it0, scr);
    p0_transpose_matrix(F, F.in[I_PLEWP], P_DIM, DM, (bf16_t*)(F.ws + WS_WPT), false, it0, scr);
    p0_cvt(F, F.in[I_X], (bf16_t*)(F.ws + WS_XB), (size_t)MTOK * DM);
    p0_cvt(F, F.in[I_P], (bf16_t*)(F.ws + WS_PB), (size_t)MTOK * P_DIM);
    p0_cvt(F, F.in[I_PSK], (bf16_t*)(F.ws + WS_SK), (size_t)PH * 2 * PNK * PHALF);
    { const int gw = F.vcu * NWAVES + F.wave, NGW = F.G * NWAVES;
      for (int r = gw; r < 2 * NEXP; r += NGW) { const int tb = r >= NEXP, e = r - tb * NEXP;
          p0_row_fp8(F.in[tb ? I_PV : I_PU] + (size_t)e * DM, F.ws + (tb ? WS_VB : WS_UB), e, (float*)(F.ws + (tb ? WS_VSC : WS_USC)) + e, F.lane); } }
}


__device__ __forceinline__ void ln_row_2048(const float* zrow, const float* g, const float* b, float* yf, bf16_t* yb, int lane) {
    const GAS f32x4* zr = (const GAS f32x4*)zrow + lane;
    f32x4 v[8]; float s = 0.f;
#pragma unroll
    for (int j = 0; j < 8; ++j) { v[j] = zr[64 * j]; s += (v[j].x + v[j].y) + (v[j].z + v[j].w); }
    const float mean = wave_sum(s) * (1.f / DM); float s2 = 0.f;
#pragma unroll
    for (int j = 0; j < 8; ++j) { v[j] = v[j] - mean; s2 += (v[j].x * v[j].x + v[j].y * v[j].y) + (v[j].z * v[j].z + v[j].w * v[j].w); }
    const float rstd = __builtin_amdgcn_rsqf(wave_sum(s2) * (1.f / DM) + LN_EPS);
#pragma unroll
    for (int j = 0; j < 8; ++j) { const f32x4 gg = ((const GAS f32x4*)g + lane)[64 * j], bb = ((const GAS f32x4*)b + lane)[64 * j]; const f32x4 y = v[j] * rstd * gg + bb;
        ((GAS f32x4*)yf + lane)[64 * j] = y; u32x2 w; w.x = pk2(y.x, y.y); w.y = pk2(y.z, y.w); ((GAS u32x2*)yb + lane)[64 * j] = w; }
}


__device__ __forceinline__ float dot2_bf16(unsigned w, unsigned x, float acc) { return __builtin_amdgcn_fdot2_f32_bf16(__builtin_bit_cast(bf16x2_t, w), __builtin_bit_cast(bf16x2_t, x), acc, false); }
__device__ __forceinline__ float dpp_row_shr(float v, int n) {
    const int iv = __builtin_bit_cast(int, v); int r;
    switch (n) { case 1: r = __builtin_amdgcn_update_dpp(0, iv, 0x111, 0xf, 0xf, true); break; case 2: r = __builtin_amdgcn_update_dpp(0, iv, 0x112, 0xf, 0xf, true); break;
                 case 4: r = __builtin_amdgcn_update_dpp(0, iv, 0x114, 0xf, 0xf, true); break; default: r = __builtin_amdgcn_update_dpp(0, iv, 0x118, 0xf, 0xf, true); break; }
    return __builtin_bit_cast(float, r);
}
__device__ __forceinline__ float wave_total(float v) {
    v += dpp_row_shr(v, 1); v += dpp_row_shr(v, 2); v += dpp_row_shr(v, 4); v += dpp_row_shr(v, 8);
    v += __builtin_bit_cast(float, __builtin_amdgcn_update_dpp(0, __builtin_bit_cast(int, v), 0x142, 0xa, 0xf, false));
    v += __builtin_bit_cast(float, __builtin_amdgcn_update_dpp(0, __builtin_bit_cast(int, v), 0x143, 0xc, 0xf, false));
    return __builtin_bit_cast(float, __builtin_amdgcn_readlane(__builtin_bit_cast(int, v), 63));
}
__device__ __forceinline__ float gelu_fast(float h) {
    const float u = 1.5957691216057308f * (h + 0.044715f * h * h * h);
    return h * __builtin_amdgcn_rcpf(1.0f + __builtin_amdgcn_exp2f(-LOG2E * u));
}
#ifndef P8_NB
#define P8_NB 4
#endif
#ifndef P8_NBU
#define P8_NBU 8
#endif
__device__ __forceinline__ int dpp_row_shr_i(int v, int n) { int r;
    switch (n) { case 1: r = __builtin_amdgcn_update_dpp(0, v, 0x111, 0xf, 0xf, true); break; case 2: r = __builtin_amdgcn_update_dpp(0, v, 0x112, 0xf, 0xf, true); break;
                 case 4: r = __builtin_amdgcn_update_dpp(0, v, 0x114, 0xf, 0xf, true); break; default: r = __builtin_amdgcn_update_dpp(0, v, 0x118, 0xf, 0xf, true); break; }
    return r; }
__device__ __forceinline__ int dpp_scan64_i(int v) {
    v += dpp_row_shr_i(v, 1); v += dpp_row_shr_i(v, 2); v += dpp_row_shr_i(v, 4); v += dpp_row_shr_i(v, 8);
    v += __builtin_amdgcn_update_dpp(0, v, 0x142, 0xa, 0xf, false); v += __builtin_amdgcn_update_dpp(0, v, 0x143, 0xc, 0xf, false); return v; }
template <int CTRL> __device__ __forceinline__ float dppf(float x) { return __builtin_bit_cast(float, __builtin_amdgcn_update_dpp(0, __builtin_bit_cast(int, x), CTRL, 0xf, 0xf, false)); }
__device__ __forceinline__ float row16_allsum(float v) { v += dppf<0x128>(v); v += dppf<0x124>(v); v += dppf<0x122>(v); v += dppf<0x121>(v); return v; }
__device__ __forceinline__ void p8_wave4(const float* x1f, int m0, const LAS int* idsL, const LAS float* gwL, LAS unsigned* lst, const unsigned char* U8, const unsigned char* V8,
                                         const float* usc, const float* vsc, const float* g2, const float* b2, float* x2f, bf16_t* x2b, int lane_in) {
    int lane = lane_in; asm volatile("" : "+v"(lane));
    LAS unsigned* sid = lst; LAS float* sw = (LAS float*)(lst + 512); LAS unsigned* bins = lst + 1024;
    for (int t = 0; t < 4; ++t) {
        bins[lane] = 0u; LDS_WAIT();
        const unsigned id0 = (unsigned)idsL[t * 128 + lane], id1 = (unsigned)idsL[t * 128 + 64 + lane]; const float ga = gwL[t * 128 + lane], gb = gwL[t * 128 + 64 + lane];
        const unsigned p0 = __hip_atomic_fetch_add(bins + (id0 >> 8), 1u, __ATOMIC_RELAXED, __HIP_MEMORY_SCOPE_WORKGROUP);
        const unsigned p1 = __hip_atomic_fetch_add(bins + (id1 >> 8), 1u, __ATOMIC_RELAXED, __HIP_MEMORY_SCOPE_WORKGROUP);
        LDS_WAIT();
        const int cnt = (int)bins[lane]; LDS_WAIT(); const int excl = dpp_scan64_i(cnt) - cnt; bins[lane] = (unsigned)excl; LDS_WAIT();
        const unsigned n0 = bins[id0 >> 8] + p0, n1 = bins[id1 >> 8] + p1;
        sid[t * 128 + n0] = id0; sw[t * 128 + n0] = ga; sid[t * 128 + n1] = id1; sw[t * 128 + n1] = gb;
        LDS_WAIT();
    }
    constexpr int NSPLIT = P8_NSPLIT, CPS = 8 / NSPLIT;
    LAS float* spart = (LAS float*)(lst + 1088);
    for (int q = 0; q < NSPLIT; ++q) {
        lane = lane_in; asm volatile("" : "+v"(lane));
        const int g = lane >> 4, i = lane & 15; const LAS unsigned* sidg = sid + g * 128; LAS float* swg = sw + g * 128; LAS float* spg = spart + g * 128;
        f32x4 xf[CPS][4];
#pragma unroll
        for (int p_ = 0; p_ < CPS; ++p_)
#pragma unroll
            for (int k = 0; k < 4; ++k) xf[p_][k] = ((const GAS f32x4*)(x1f + (size_t)(m0 + g) * DM))[4 * (16 * CPS * q + i + 16 * p_) + k];
        u32x4 r0[P8_NBU][CPS], r1[P8_NBU][CPS]; float sc0[P8_NBU], sc1[P8_NBU];
#define P8_ULOAD(R, SC, n_) do { _Pragma("unroll") for (int jj = 0; jj < P8_NBU; ++jj) { const unsigned id = sidg[(n_) + jj]; const GAS u32x4* rp = (const GAS u32x4*)(U8 + ((size_t)q * NEXP + id) * (DM / NSPLIT)) + i; SC[jj] = usc[id]; \
                _Pragma("unroll") for (int p_ = 0; p_ < CPS; ++p_) R[jj][p_] = rp[16 * p_]; } } while (0)
#define P8_UCOMP(R, SC, n_) do { _Pragma("unroll") for (int jj = 0; jj < P8_NBU; ++jj) { f32x2 a0 = {0.f, 0.f}, a1 = {0.f, 0.f}; \
                _Pragma("unroll") for (int p_ = 0; p_ < CPS; ++p_) _Pragma("unroll") for (int k = 0; k < 4; ++k) { const int dw = (int)R[jj][p_][k]; const f32x4 xv = xf[p_][k]; \
                    a0 = __builtin_amdgcn_cvt_pk_f32_fp8(dw, false) * (f32x2){xv.x, xv.y} + a0; a1 = __builtin_amdgcn_cvt_pk_f32_fp8(dw, true) * (f32x2){xv.z, xv.w} + a1; } \
                float d = row16_allsum((a0.x + a0.y) + (a1.x + a1.y)); \
                if (q > 0) d += spg[(n_) + jj]; \
                if (q < NSPLIT - 1) { if (i == 0) spg[(n_) + jj] = d; } \
                else { const float wv = swg[(n_) + jj] * gelu_fast(d * SC[jj]); if (i == 0) swg[(n_) + jj] = wv; } } } while (0)
        P8_ULOAD(r0, sc0, 0);
        for (int n = 0; n < 128; n += 2 * P8_NBU) {
            P8_ULOAD(r1, sc1, n + P8_NBU);
            P8_UCOMP(r0, sc0, n);
            if (n + 2 * P8_NBU < 128) P8_ULOAD(r0, sc0, n + 2 * P8_NBU);
            P8_UCOMP(r1, sc1, n + P8_NBU);
        }
#undef P8_ULOAD
#undef P8_UCOMP
        LDS_WAIT();
    }
    f32x2 acc[NSPLIT][CPS][4][2];
#pragma unroll
    for (int q = 0; q < NSPLIT; ++q) {
        lane = lane_in; asm volatile("" : "+v"(lane));
        const int g_ = lane >> 4, i_ = lane & 15; const LAS unsigned* sidv = sid + g_ * 128; const LAS float* swv = sw + g_ * 128;
#pragma unroll
        for (int p_ = 0; p_ < CPS; ++p_)
#pragma unroll
            for (int k = 0; k < 4; ++k) { acc[q][p_][k][0] = (f32x2){0.f, 0.f}; acc[q][p_][k][1] = (f32x2){0.f, 0.f}; }
        u32x4 r0[P8_NB][CPS], r1[P8_NB][CPS]; float w0_[P8_NB], w1_[P8_NB];
#define P8_VLOAD(R, W, n_) do { _Pragma("unroll") for (int jj = 0; jj < P8_NB; ++jj) { const unsigned id = sidv[(n_) + jj]; const GAS u32x4* rp = (const GAS u32x4*)(V8 + ((size_t)q * NEXP + id) * (DM / NSPLIT)) + i_; W[jj] = vsc[id] * swv[(n_) + jj]; \
                _Pragma("unroll") for (int p_ = 0; p_ < CPS; ++p_) R[jj][p_] = rp[16 * p_]; } } while (0)
#define P8_VCOMP(R, W) do { _Pragma("unroll") for (int jj = 0; jj < P8_NB; ++jj) { const f32x2 w2 = {W[jj], W[jj]}; \
                _Pragma("unroll") for (int p_ = 0; p_ < CPS; ++p_) _Pragma("unroll") for (int k = 0; k < 4; ++k) { const int dw = (int)R[jj][p_][k]; \
                    acc[q][p_][k][0] = __builtin_amdgcn_cvt_pk_f32_fp8(dw, false) * w2 + acc[q][p_][k][0]; acc[q][p_][k][1] = __builtin_amdgcn_cvt_pk_f32_fp8(dw, true) * w2 + acc[q][p_][k][1]; } } } while (0)
        P8_VLOAD(r0, w0_, 0);
        for (int n = 0; n < 128; n += 2 * P8_NB) {
            P8_VLOAD(r1, w1_, n + P8_NB);
            P8_VCOMP(r0, w0_);
            if (n + 2 * P8_NB < 128) P8_VLOAD(r0, w0_, n + 2 * P8_NB);
            P8_VCOMP(r1, w1_);
        }
#undef P8_VLOAD
#undef P8_VCOMP
    }
    lane = lane_in; asm volatile("" : "+v"(lane));
    {
        const int g_ = lane >> 4, i_ = lane & 15; const size_t m = (size_t)(m0 + g_);
        const GAS f32x4* xr = (const GAS f32x4*)(x1f + m * DM); float s_ = 0.f;
#pragma unroll
        for (int q = 0; q < NSPLIT; ++q)
#pragma unroll
            for (int p_ = 0; p_ < CPS; ++p_)
#pragma unroll
                for (int k = 0; k < 4; ++k) { const f32x4 xv = xr[4 * (16 * CPS * q + i_ + 16 * p_) + k];
                    acc[q][p_][k][0] = acc[q][p_][k][0] + (f32x2){xv.x, xv.y} * ALPHA; acc[q][p_][k][1] = acc[q][p_][k][1] + (f32x2){xv.z, xv.w} * ALPHA;
                    s_ += (acc[q][p_][k][0].x + acc[q][p_][k][0].y) + (acc[q][p_][k][1].x + acc[q][p_][k][1].y); }
        const float mean = row16_allsum(s_) * (1.f / DM); float s2 = 0.f;
#pragma unroll
        for (int q = 0; q < NSPLIT; ++q)
#pragma unroll
            for (int p_ = 0; p_ < CPS; ++p_)
#pragma unroll
                for (int k = 0; k < 4; ++k) { acc[q][p_][k][0] = acc[q][p_][k][0] - mean; acc[q][p_][k][1] = acc[q][p_][k][1] - mean;
                    s2 += (acc[q][p_][k][0].x * acc[q][p_][k][0].x + acc[q][p_][k][0].y * acc[q][p_][k][0].y) + (acc[q][p_][k][1].x * acc[q][p_][k][1].x + acc[q][p_][k][1].y * acc[q][p_][k][1].y); }
        const float rstd = __builtin_amdgcn_rsqf(row16_allsum(s2) * (1.f / DM) + LN_EPS);
#pragma unroll
        for (int q = 0; q < NSPLIT; ++q)
#pragma unroll
            for (int p_ = 0; p_ < CPS; ++p_) { unsigned pkw[8]; const int ch = 16 * CPS * q + i_ + 16 * p_;
#pragma unroll
                for (int k = 0; k < 4; ++k) { const int ci = 4 * ch + k; const f32x4 gg = ((const GAS f32x4*)g2)[ci], bb = ((const GAS f32x4*)b2)[ci];
                    const f32x4 y = {acc[q][p_][k][0].x * rstd * gg.x + bb.x, acc[q][p_][k][0].y * rstd * gg.y + bb.y, acc[q][p_][k][1].x * rstd * gg.z + bb.z, acc[q][p_][k][1].y * rstd * gg.w + bb.w};
                    ((GAS f32x4*)(x2f + m * DM))[ci] = y; pkw[2 * k] = pk2(y.x, y.y); pkw[2 * k + 1] = pk2(y.z, y.w); }
                ((GAS u32x4*)(x2b + m * DM))[2 * ch] = (u32x4){pkw[0], pkw[1], pkw[2], pkw[3]}; ((GAS u32x4*)(x2b + m * DM))[2 * ch + 1] = (u32x4){pkw[4], pkw[5], pkw[6], pkw[7]}; }
    }
}

__device__ __forceinline__ int f2key(float v) { const int b = __builtin_bit_cast(int, v); return b ^ ((b >> 31) & 0x7fffffff); }
__device__ __forceinline__ float key2f(int k) { const int b = k ^ ((k >> 31) & 0x7fffffff); return __builtin_bit_cast(float, b); }
__device__ __forceinline__ void cmpx(int& a, int& b) { const int mx = a > b ? a : b, mn = a > b ? b : a; a = mx; b = mn; }
template <int N> __device__ __forceinline__ void bitonic_merge_desc(int (&k)[N]) {
#pragma unroll
    for (int stride = N / 2; stride > 0; stride >>= 1)
#pragma unroll
        for (int i = 0; i < N; ++i) { const int j = i ^ stride; if (j > i) cmpx(k[i], k[j]); }
}
template <int N> __device__ __forceinline__ void bitonic_sort_desc(int (&k)[N]) {
#pragma unroll
    for (int size = 2; size <= N; size <<= 1)
#pragma unroll
        for (int stride = size >> 1; stride > 0; stride >>= 1)
#pragma unroll
            for (int i = 0; i < N; ++i) { const int j = i ^ stride; if (j > i) { if ((i & size) == 0 || size == N) cmpx(k[i], k[j]); else cmpx(k[j], k[i]); } }
}
__device__ __forceinline__ void top16_merge(int (&a)[16], const int (&b)[16]) {
#pragma unroll
    for (int i = 0; i < 16; ++i) a[i] = a[i] > b[15 - i] ? a[i] : b[15 - i];
    bitonic_merge_desc<16>(a);
}
__device__ __forceinline__ void top16_of_64(int (&g0)[16], int (&g1)[16], int (&g2)[16], int (&g3)[16]) {
    bitonic_sort_desc<16>(g0); bitonic_sort_desc<16>(g1); bitonic_sort_desc<16>(g2); bitonic_sort_desc<16>(g3);
    top16_merge(g0, g1); top16_merge(g2, g3); top16_merge(g0, g2);
}
__device__ __forceinline__ void p7_tile(const bf16_t* qp, const bf16_t* SK, LAS int* ids  , LAS float* gwt, int tok0, int h, LAS int* scr  , int lane) {
    const int r32 = lane & 31, hi = lane >> 5;
    int top[2][16];
#pragma unroll
    for (int c = 0; c < 2; ++c) {
        const int hc = h * 2 + c;
        f32x16 acc[4];
#pragma unroll
        for (int nb = 0; nb < 4; ++nb) acc[nb] = f32x16{};
        const bf16_t* qrow = qp + (size_t)(tok0 + r32) * DM + hc * 128 + 8 * hi;
        const bf16_t* krow = SK + ((size_t)hc * 128 + r32) * 128 + 8 * hi;
#pragma unroll 2
        for (int ks = 0; ks < 8; ++ks) {
            const bf16x8 qf = *(const GAS bf16x8*)(qrow + 16 * ks);
#pragma unroll
            for (int nb = 0; nb < 4; ++nb) { const bf16x8 kf = *(const GAS bf16x8*)(krow + (size_t)nb * 32 * 128 + 16 * ks); acc[nb] = __builtin_amdgcn_mfma_f32_32x32x16_bf16(kf, qf, acc[nb], 0, 0, 0); }
        }
        int g[4][16];
#pragma unroll
        for (int nb = 0; nb < 4; ++nb)
#pragma unroll
            for (int r = 0; r < 16; ++r) { const int n = 32 * nb + 8 * (r >> 2) + 4 * hi + (r & 3); g[nb][r] = (f2key(acc[nb][r]) & ~0x7f) | (127 - n); }
        top16_of_64(g[0], g[1], g[2], g[3]);
        int lo_[16], hi_[16];
#pragma unroll
        for (int i = 0; i < 16; ++i) { auto rr = __builtin_amdgcn_permlane32_swap((unsigned)g[0][i], (unsigned)g[0][i], false, false); lo_[i] = (int)rr[0]; hi_[i] = (int)rr[1]; }
        top16_merge(lo_, hi_);
#pragma unroll
        for (int i = 0; i < 16; ++i) top[c][i] = lo_[i];
    }
#pragma unroll
    for (int c = 0; c < 2; ++c)
#pragma unroll
        for (int i = 0; i < 16; ++i) scr[(16 * c + i) * 64 + lane] = 127 - (top[c][i] & 0x7f);
    int cg[4][16];
    {
        int cnt = 0;
#pragma unroll
        for (int i = 0; i < 16; ++i)
#pragma unroll
            for (int j = 0; j < 16; ++j) if ((i + 1) * (j + 1) <= 16) {
                const float sum = key2f(top[0][i] & ~0x7f) + key2f(top[1][j] & ~0x7f);
                cg[cnt >> 4][cnt & 15] = (f2key(sum) & ~0xff) | (255 - ((i << 4) | j)); ++cnt; }
#pragma unroll
        for (int q = 50; q < 64; ++q) cg[q >> 4][q & 15] = (int)0x80000000;
    }
    top16_of_64(cg[0], cg[1], cg[2], cg[3]);
    LDS_WAIT();
    float e[16]; float sum = 0.f; const float smax = key2f(cg[0][0] & ~0xff);
#pragma unroll
    for (int r = 0; r < 16; ++r) { e[r] = __builtin_amdgcn_exp2f((key2f(cg[0][r] & ~0xff) - smax) * LOG2E); sum += e[r]; }
    const float inv = __builtin_amdgcn_rcpf(sum);
    if (hi == 0) {
        LAS int* ip = ids + r32 * 128 + h * 16; LAS float* gp = gwt + r32 * 128 + h * 16;
#pragma unroll
        for (int r = 0; r < 16; ++r) { const int pay = 255 - (cg[0][r] & 0xff); const int i0 = scr[(pay >> 4) * 64 + lane], i1 = scr[(16 + (pay & 15)) * 64 + lane];
            ip[r] = i0 * PNK + i1; gp[r] = e[r] * inv; }
    }
    LDS_WAIT();
}


__device__ __forceinline__ float dpp_scan64(float v) {
    v += dpp_row_shr(v, 1); v += dpp_row_shr(v, 2); v += dpp_row_shr(v, 4); v += dpp_row_shr(v, 8);
    v += __builtin_bit_cast(float, __builtin_amdgcn_update_dpp(0, __builtin_bit_cast(int, v), 0x142, 0xa, 0xf, false));
    v += __builtin_bit_cast(float, __builtin_amdgcn_update_dpp(0, __builtin_bit_cast(int, v), 0x143, 0xc, 0xf, false));
    return v;
}
template <int R> __device__ __forceinline__ void conv_rows(f32x2 (&y)[16], const f32x2 (&w)[31], const unsigned (&xin)[46]) {
    const f32x2 xv = {bflo(xin[R]), bfhi(xin[R])};
    constexpr int tlo = R - 30 < 0 ? 0 : R - 30, thi = R < 16 ? R : 15;
#pragma unroll
    for (int t = tlo; t <= thi; ++t) y[t] = y[t] + w[R - t] * xv;
    if constexpr (R + 1 < 46) conv_rows<R + 1>(y, w, xin);
}
__device__ __forceinline__ void p2_conv_item(const bf16_t* hglu, const float* dww, const float* dwb, const float* lng, const float* lnb, bf16_t* hc, int tok0, LAS float* red  , int tid) {
    const int c0 = 2 * tid, s0 = tok0 % SEQ, lane = tid & 63, wave = tid >> 6;
    unsigned xin[46];
#pragma unroll
    for (int r = 0; r < 46; ++r) { const bool ok = (s0 - 30 + r) >= 0; xin[r] = ok ? *(const GAS unsigned*)(hglu + (size_t)(tok0 - 30 + r) * CONV_CH + c0) : 0u; }
    f32x2 w[31];
#pragma unroll
    for (int j = 0; j < 31; ++j) w[j] = *(const GAS f32x2*)(dww + j * CONV_CH + c0);
    const f32x2 bias = *(const GAS f32x2*)(dwb + c0);
    f32x2 y[16];
#pragma unroll
    for (int t = 0; t < 16; ++t) y[t] = bias;
    conv_rows<0>(y, w, xin);
#pragma unroll
    for (int t = 0; t < 16; ++t) { const float ps = dpp_scan64(y[t].x + y[t].y), pq = dpp_scan64(y[t].x * y[t].x + y[t].y * y[t].y);
        if (lane == 63) { red[(2 * t) * 8 + wave] = ps; red[(2 * t + 1) * 8 + wave] = pq; } }
    LDS_WAIT(); __syncthreads();
    if (tid < 32) { float a = 0.f;
#pragma unroll
        for (int k = 0; k < 8; ++k) a += red[tid * 8 + k];
        red[256 + tid] = a; }
    LDS_WAIT(); __syncthreads();
    const f32x2 g = *(const GAS f32x2*)(lng + c0), bb = *(const GAS f32x2*)(lnb + c0);
#pragma unroll
    for (int t = 0; t < 16; ++t) { const float mean = red[256 + 2 * t] * (1.f / CONV_CH), ex2 = red[256 + 2 * t + 1] * (1.f / CONV_CH);
        const float rstd = __builtin_amdgcn_rsqf(ex2 - mean * mean + LN_EPS);
        const float v0 = (y[t].x - mean) * rstd * g.x + bb.x, v1 = (y[t].y - mean) * rstd * g.y + bb.y;
        *(GAS unsigned*)(hc + (size_t)(tok0 + t) * CONV_CH + c0) = pk2(v0 * fsigmoid(v0), v1 * fsigmoid(v1)); }
    __syncthreads();
}

constexpr int AT_KBYTES = 8192, AT_VPITCH = 136, AT_VBYTES = 128 * AT_VPITCH, AT_BUF = 2 * AT_KBYTES + AT_VBYTES;
constexpr int AT_WSF = 2 * AT_BUF;
constexpr int AT_XCH = 0;
static_assert(AT_WSF + 8 * 128 <= RING_BYTES && 4 * 32 * 128 * 4 <= AT_WSF, "attention LDS map");
__device__ __forceinline__ int crow(int r, int hi) { return (r & 3) + 8 * (r >> 2) + 4 * hi; }
__device__ __forceinline__ void p2_attn_unit(const bf16_t* Qb, const bf16_t* Kb, const bf16_t* VT, bf16_t* on, const float* subg, float lam, int b, int h, int qb, LAS unsigned char* lds, int tid) {
    const int lane = tid & 63, r32 = lane & 31, hi = lane >> 5, wid = __builtin_amdgcn_readfirstlane(tid >> 6), map = wid >> 2, wq = wid & 3;
    const size_t rowb = (size_t)b * SEQ; const int q0 = 128 * qb + 32 * wq;
    const int NT = 2 * (qb + 1);
    const float sl = __builtin_amdgcn_exp2f(-(float)(h + 1)) * LOG2E;
    const bf16_t* kg[2]; int kl[2]; const bf16_t* vg[2]; int vl[2];
#pragma unroll
    for (int i = 0; i < 2; ++i) { const int p = tid + 512 * i, mp = p >> 9, key = p & 63, ch = (p >> 6) & 7;
        kg[i] = Kb + (rowb + key) * 1024 + h * 128 + mp * 64 + 8 * ch; kl[i] = mp * AT_KBYTES + ch * 1024 + key * 16;
        const int row = p >> 3, vc = p & 7; vg[i] = VT + (size_t)(h * 128 + row) * MTOK + rowb + 8 * vc; vl[i] = 2 * AT_KBYTES + row * AT_VPITCH + vc * 16; }
    u32x4 ks[2], vs[2];
#define AT_LOAD(t) do { _Pragma("unroll") for (int i_ = 0; i_ < 2; ++i_) { ks[i_] = *(const GAS u32x4*)(kg[i_] + (size_t)(t) * 64 * 1024); vs[i_] = *(const GAS u32x4*)(vg[i_] + (t) * 64); } } while (0)
#define AT_STORE(bufo) do { _Pragma("unroll") for (int i_ = 0; i_ < 2; ++i_) { *(LAS u32x4*)(lds + (bufo) + kl[i_]) = ks[i_]; \
        *(LAS u32x2*)(lds + (bufo) + vl[i_]) = (u32x2){vs[i_].x, vs[i_].y}; *(LAS u32x2*)(lds + (bufo) + vl[i_] + 8) = (u32x2){vs[i_].z, vs[i_].w}; } } while (0)
    AT_LOAD(0);
    bf16x8 qr[4];
#pragma unroll
    for (int d0 = 0; d0 < 4; ++d0) qr[d0] = *(const GAS bf16x8*)(Qb + (rowb + q0 + r32) * 1024 + h * 128 + map * 64 + 16 * d0 + 8 * hi);
    f32x16 o[4];
#pragma unroll
    for (int d0 = 0; d0 < 4; ++d0) o[d0] = f32x16{};
    float mrun = 0.f, lsum = 0.f;
    LAS float* wsf = (LAS float*)(lds + AT_WSF) + wid * 32;
    AT_STORE(0);
    LDS_WAIT(); __syncthreads();
    for (int t = 0; t < NT; ++t) {
        const int bufo = (t & 1) * AT_BUF;
        if (t + 1 < NT) AT_LOAD(t + 1);
        f32x16 x[2];
        { const float base = sl * (float)(64 * t + 4 * hi) - mrun;
#pragma unroll
          for (int r = 0; r < 16; ++r) { x[0][r] = fmaf(sl, (float)crow(r, 0), base); x[1][r] = fmaf(sl, (float)(crow(r, 0) + 32), base); } }
        const LAS unsigned char* kb_ = lds + bufo + map * AT_KBYTES + hi * 1024 + r32 * 16;
#pragma unroll
        for (int d0 = 0; d0 < 4; ++d0) {
            const bf16x8 k0 = *(const LAS bf16x8*)(kb_ + d0 * 2048), k1 = *(const LAS bf16x8*)(kb_ + d0 * 2048 + 512);
            x[0] = __builtin_amdgcn_mfma_f32_32x32x16_bf16(k0, qr[d0], x[0], 0, 0, 0);
            x[1] = __builtin_amdgcn_mfma_f32_32x32x16_bf16(k1, qr[d0], x[1], 0, 0, 0);
        }
        if (t >= NT - 2) {
            const int qrel = 32 * wq + r32, kb0 = 64 * (t - (NT - 2));
#pragma unroll
            for (int r = 0; r < 16; ++r) { const int kr = kb0 + crow(r, hi); if (kr > qrel) x[0][r] = -INFINITY; if (kr + 32 > qrel) x[1][r] = -INFINITY; }
        }
        float rm = fmaxf(x[0][0], x[1][0]);
#pragma unroll
        for (int r = 1; r < 16; ++r) rm = fmaxf(rm, fmaxf(x[0][r], x[1][r]));
        { auto rr = __builtin_amdgcn_permlane32_swap(__float_as_uint(rm), __float_as_uint(rm), false, false); rm = fmaxf(__uint_as_float(rr[0]), __uint_as_float(rr[1])); }
        const bool resc = (t == 0) || __any(rm > 6.0f);
        if (resc) {
            const float dl = (t == 0) ? rm : fmaxf(rm, 0.f); mrun += dl;
#pragma unroll
            for (int r = 0; r < 16; ++r) { x[0][r] -= dl; x[1][r] -= dl; }
            if (t > 0) { const float f = __builtin_amdgcn_exp2f(-dl); lsum *= f; if (hi == 0) wsf[r32] = f; LDS_WAIT();
#pragma unroll
                for (int r = 0; r < 16; ++r) { const float fr_ = wsf[crow(r, hi)];
#pragma unroll
                    for (int d0 = 0; d0 < 4; ++d0) o[d0][r] *= fr_; } }
        }
        u32x4 pa[4];
#pragma unroll
        for (int kb = 0; kb < 2; ++kb) {
#pragma unroll
            for (int r = 0; r < 16; ++r) { x[kb][r] = __builtin_amdgcn_exp2f(x[kb][r]); lsum += x[kb][r]; }
#pragma unroll
            for (int sp = 0; sp < 2; ++sp) pa[2 * kb + sp] = (u32x4){pk2(x[kb][8 * sp + 0], x[kb][8 * sp + 1]), pk2(x[kb][8 * sp + 2], x[kb][8 * sp + 3]), pk2(x[kb][8 * sp + 4], x[kb][8 * sp + 5]), pk2(x[kb][8 * sp + 6], x[kb][8 * sp + 7])};
        }
        const LAS unsigned char* vb_ = lds + bufo + 2 * AT_KBYTES + r32 * AT_VPITCH + hi * 8;
#pragma unroll
        for (int d0 = 0; d0 < 4; ++d0)
#pragma unroll
            for (int s_ = 0; s_ < 4; ++s_) { const u32x2 lo = *(const LAS u32x2*)(vb_ + d0 * 32 * AT_VPITCH + s_ * 32), hh = *(const LAS u32x2*)(vb_ + d0 * 32 * AT_VPITCH + s_ * 32 + 16);
                const u32x4 vf = {lo.x, lo.y, hh.x, hh.y};
                o[d0] = __builtin_amdgcn_mfma_f32_32x32x16_bf16(__builtin_bit_cast(bf16x8, pa[s_]), __builtin_bit_cast(bf16x8, vf), o[d0], 0, 0, 0); }
        if (t + 1 < NT) AT_STORE(((t + 1) & 1) * AT_BUF);
        LDS_WAIT(); __syncthreads();
    }
    { auto rr = __builtin_amdgcn_permlane32_swap(__float_as_uint(lsum), __float_as_uint(lsum), false, false); lsum = __uint_as_float(rr[0]) + __uint_as_float(rr[1]); }
    if (hi == 0) wsf[r32] = ((map == 0) ? 1.0f : lam) / lsum;
    LDS_WAIT();
#pragma unroll
    for (int r = 0; r < 16; ++r) { const float il = wsf[crow(r, hi)];
#pragma unroll
        for (int d0 = 0; d0 < 4; ++d0) o[d0][r] *= il; }
    LAS float* xch = (LAS float*)(lds + AT_XCH) + wq * (32 * 128);
    if (map == 1) {
#pragma unroll
        for (int r = 0; r < 16; ++r)
#pragma unroll
            for (int d0 = 0; d0 < 4; ++d0) xch[crow(r, hi) * 128 + 32 * d0 + r32] = o[d0][r];
    }
    LDS_WAIT(); __syncthreads();
    if (map == 0) {
        float ss[16];
#pragma unroll
        for (int r = 0; r < 16; ++r) { float a = 0.f;
#pragma unroll
            for (int d0 = 0; d0 < 4; ++d0) { o[d0][r] -= xch[crow(r, hi) * 128 + 32 * d0 + r32]; a += o[d0][r] * o[d0][r]; }
            ss[r] = a; }
#pragma unroll
        for (int r = 0; r < 16; ++r) { float a = ss[r]; a += __shfl_xor(a, 1); a += __shfl_xor(a, 2); a += __shfl_xor(a, 4); a += __shfl_xor(a, 8); a += __shfl_xor(a, 16);
            ss[r] = __builtin_amdgcn_rsqf(a * (1.f / 128.f) + LN_EPS) * (1.0f - LAM_INIT); }
        float gsub[4];
#pragma unroll
        for (int d0 = 0; d0 < 4; ++d0) gsub[d0] = subg[32 * d0 + r32];
#pragma unroll
        for (int r = 0; r < 16; ++r) { bf16_t* orow = on + (rowb + q0 + crow(r, hi)) * 1024 + h * 128 + r32;
#pragma unroll
            for (int d0 = 0; d0 < 4; ++d0) orow[32 * d0] = (bf16_t)f2bf(o[d0][r] * ss[r] * gsub[d0]); }
    }
    __syncthreads();
#undef AT_LOAD
#undef AT_STORE
}

constexpr int CW_BAR = 4096;
constexpr size_t CTL_ZERO_BYTES = 64 * 1024;
#ifndef REP_PHASE
#define REP_PHASE -1
#endif
#define REPS(k) for (int rep_ = 0; rep_ < ((REP_PHASE == (k)) ? 2 : 1); ++rep_)
enum { PH_P0 = 0, PH_P1, PH_P2, PH_P3, PH_P4, PH_P5, PH_P6, PH_P7, PH_P9, PH_END };

__global__ void __launch_bounds__(NTHREADS, 2) mk_fwd(Args args) {
    extern __shared__ __attribute__((aligned(16))) unsigned char lds_raw[];
    Frame F;
    F.lds = (LAS unsigned char*)lds_raw;
    F.tid = threadIdx.x; F.lane = F.tid & 63; F.wave = __builtin_amdgcn_readfirstlane(F.tid >> 6);
    F.G = gridDim.x; { const int bx = blockIdx.x; F.vcu = (F.G % 8 == 0) ? (bx % 8) * (F.G / 8) + bx / 8 : bx; }
    F.in = args.in; F.ws = args.ws; F.out = args.out;
    volatile LAS unsigned* MISC = (volatile LAS unsigned*)(F.lds + MISC_OFF);
    for (int u = F.tid; u < (LDS_BYTES - MISC_OFF) / 4; u += NTHREADS) MISC[u] = 0u;
    __syncthreads();
    const int lo = args.ph_lo, hi = args.ph_hi;
    XcdBarrier bar; bar.bar = (unsigned*)(F.ws + WS_CTL) + CW_BAR; bar.x = 0; bar.st = nullptr;
    if (hi - lo > 1) bar = xcd_barrier_post((unsigned*)(F.ws + WS_CTL) + CW_BAR, MISC + 8);
#define IN(k) (lo <= (k) && (k) < hi)
#define SEAM(k) do { if (IN(k) && IN((k) + 1)) xcd_barrier(bar); } while (0)
    unsigned char* ws = F.ws;
    if (IN(PH_P0)) { REPS(0) p0_prologue(F); SEAM(PH_P0); }
    if (IN(PH_P1)) { REPS(1) {
        { pg8::Gemm g{(const bf16_t*)(ws + WS_XB), (const bf16_t*)(ws + WS_WINT), DM, DM, DM}; pg8::StaticOrder S; S.init(MTOK, 8192, F.G, (int)blockIdx.x);
          EpiP1 E{(bf16_t*)(ws + WS_HGLU), (bf16_t*)(ws + WS_QB), (bf16_t*)(ws + WS_KB), (bf16_t*)(ws + WS_GT), F.in[I_BGATE]};
          pg8::gemm_phase<EpiP1>(F.lds, g, S, E); }
        { pg8::Gemm g{(const bf16_t*)(ws + WS_WINT) + (size_t)8192 * DM, (const bf16_t*)(ws + WS_XB), DM, DM, DM}; pg8::StaticOrder S; S.init(1024, MTOK, F.G, (int)blockIdx.x);
          EpiBf16 E{(bf16_t*)(ws + WS_VT), MTOK};
          pg8::gemm_phase<EpiBf16>(F.lds, g, S, E); }
        }
        SEAM(PH_P1);
    }

    if (IN(PH_P2)) { REPS(2) {
        int tid_ = F.tid; asm volatile("" : "+v"(tid_));
        for (int it = F.vcu * 2; it < MTOK / 16; it += F.G * 2) {
            p2_conv_item((const bf16_t*)(ws + WS_HGLU), F.in[I_DWW], F.in[I_DWB], F.in[I_CLNG], F.in[I_CLNB], (bf16_t*)(ws + WS_HC), it * 16, (LAS float*)F.lds, tid_);
            p2_conv_item((const bf16_t*)(ws + WS_HGLU), F.in[I_DWW], F.in[I_DWB], F.in[I_CLNG], F.in[I_CLNB], (bf16_t*)(ws + WS_HC), it * 16 + 16, (LAS float*)F.lds, tid_); }
        float lam;
        { float a = 0.f, c = 0.f; for (int i = 0; i < 64; ++i) { a += F.in[I_LQ1][i] * F.in[I_LK1][i]; c += F.in[I_LQ2][i] * F.in[I_LK2][i]; } lam = __expf(a) - __expf(c) + LAM_INIT; }
        for (int it = F.vcu; it < BATCH * AH * 8; it += F.G) { const int bh = it >> 3, s_ = it & 7;
            p2_attn_unit((const bf16_t*)(ws + WS_QB), (const bf16_t*)(ws + WS_KB), (const bf16_t*)(ws + WS_VT), (bf16_t*)(ws + WS_ON), F.in[I_SUBLN], lam, bh / AH, bh % AH, 15 - s_, F.lds, tid_);
            p2_attn_unit((const bf16_t*)(ws + WS_QB), (const bf16_t*)(ws + WS_KB), (const bf16_t*)(ws + WS_VT), (bf16_t*)(ws + WS_ON), F.in[I_SUBLN], lam, bh / AH, bh % AH, s_, F.lds, tid_); }
        }
        SEAM(PH_P2);
    }
    if (IN(PH_P3)) { REPS(3) {
        pg8::StaticOrder S; S.init(MTOK, DM, F.G, (int)blockIdx.x);
        { pg8::Gemm g{(const bf16_t*)(ws + WS_HC), (const bf16_t*)(ws + WS_WCT), 1024, 1024, 1024};
          EpiF32<0> E{(float*)(ws + WS_T1), (const bf16_t*)(ws + WS_GT), nullptr, nullptr, nullptr, nullptr}; pg8::gemm_phase<EpiF32<0>>(F.lds, g, S, E); }
        { pg8::Gemm g{(const bf16_t*)(ws + WS_ON), (const bf16_t*)(ws + WS_WOT), 1024, 1024, 1024};
          EpiF32<1> E{(float*)(ws + WS_T1), (const bf16_t*)(ws + WS_GT), (bf16_t*)(ws + WS_MIXED), nullptr, nullptr, nullptr}; pg8::gemm_phase<EpiF32<1>>(F.lds, g, S, E); }
        }
        SEAM(PH_P3);
    }
    if (IN(PH_P4)) { REPS(4) {
        pg8::StaticOrder S; S.init(MTOK, DM, F.G, (int)blockIdx.x);
        pg8::Gemm g{(const bf16_t*)(ws + WS_MIXED), (const bf16_t*)(ws + WS_WOUTT), DM, DM, DM};
        EpiF32<2> E{nullptr, nullptr, nullptr, F.in[I_X], (float*)(ws + WS_X1F), nullptr}; pg8::gemm_phase<EpiF32<2>>(F.lds, g, S, E);
        }
        SEAM(PH_P4);
    }
    if (IN(PH_P5)) { REPS(5) {
        const int gw = F.vcu * NWAVES + F.wave, NGW = F.G * NWAVES;
        for (int m = gw; m < MTOK; m += NGW) ln_row_2048((const float*)(ws + WS_X1F) + (size_t)m * DM, F.in[I_LN1G], F.in[I_LN1B], (float*)(ws + WS_X1F) + (size_t)m * DM, (bf16_t*)(ws + WS_X1B) + (size_t)m * DM, F.lane);
        }
        SEAM(PH_P5);
    }
    if (IN(PH_P6)) { REPS(6) {
        pg8::StaticOrder S; S.init(MTOK, DM, F.G, (int)blockIdx.x);
        pg8::Gemm g{(const bf16_t*)(ws + WS_X1B), (const bf16_t*)(ws + WS_WQT), DM, DM, DM};
        EpiBf16 E{(bf16_t*)(ws + WS_QP), DM}; pg8::gemm_phase<EpiBf16>(F.lds, g, S, E);
        }
        SEAM(PH_P6);
    }
    if (IN(PH_P7)) { REPS(7) {
        int lane_ = F.lane; asm volatile("" : "+v"(lane_));
        LAS int* idsL = (LAS int*)(F.lds + 65536); LAS float* gwL = (LAS float*)(F.lds + 65536 + 16384);
        for (int tile = F.vcu; tile < MTOK / 32; tile += F.G) { const int tok0 = tile * 32;
            p7_tile((const bf16_t*)(ws + WS_QP), (const bf16_t*)(ws + WS_SK), idsL, gwL, tok0, F.wave, (LAS int*)(F.lds + F.wave * 8192), lane_);
            LDS_WAIT(); __syncthreads(); asm volatile("" : "+v"(lane_));
            p8_wave4((const float*)(ws + WS_X1F), tok0 + 4 * F.wave, idsL + 4 * F.wave * 128, gwL + 4 * F.wave * 128, (LAS unsigned*)(F.lds + 98304 + F.wave * 6656),
                     (const unsigned char*)(ws + WS_UB), (const unsigned char*)(ws + WS_VB), (const float*)(ws + WS_USC), (const float*)(ws + WS_VSC),
                     F.in[I_LN2G], F.in[I_LN2B], (float*)(ws + WS_X2F), (bf16_t*)(ws + WS_X2B), lane_);
            __syncthreads(); }
        }
        SEAM(PH_P7);
    }
    if (IN(PH_P9)) { REPS(9) {
        pg8::StaticOrder S; S.init(MTOK, DM, F.G, (int)blockIdx.x);
        { pg8::Gemm g{(const bf16_t*)(ws + WS_PB), (const bf16_t*)(ws + WS_WPT), P_DIM, P_DIM, P_DIM};
          EpiF32<3> E{(float*)(ws + WS_E), nullptr, nullptr, nullptr, nullptr, nullptr}; pg8::gemm_phase<EpiF32<3>>(F.lds, g, S, E); }
        { pg8::Gemm g{(const bf16_t*)(ws + WS_X2B), (const bf16_t*)(ws + WS_WPGT), DM, DM, DM};
          EpiF32<4> E{(float*)(ws + WS_E), nullptr, nullptr, (const float*)(ws + WS_X2F), F.out, F.in[I_PLEBG]}; pg8::gemm_phase<EpiF32<4>>(F.lds, g, S, E); }
        }
    }
#undef IN
#undef SEAM
}
extern "C" void kernel_launch(void* const* d_in, const int* in_sizes, int n_in, void* d_out, int out_size, void* d_ws, size_t ws_size, hipStream_t stream) {
    static int grid = 0;
    if (grid == 0) {
        if (n_in != N_IN || ws_size < WS_END) { fprintf(stderr, "kernel_launch: unexpected n_in %d / ws_size %zu\n", n_in, ws_size); grid = -1; return; }
        int dev = 0, cus = 0;
        if (hipGetDevice(&dev) != hipSuccess || hipDeviceGetAttribute(&cus, hipDeviceAttributeMultiprocessorCount, dev) != hipSuccess) { grid = -1; return; }
        if (hipFuncSetAttribute((const void*)mk_fwd, hipFuncAttributeMaxDynamicSharedMemorySize, LDS_BYTES) != hipSuccess) { fprintf(stderr, "kernel_launch: hipFuncSetAttribute failed\n"); grid = -1; return; }
        (void)hipGetLastError();
        grid = cus;
    }
    if (grid < 0) return;
    (void)hipMemsetAsync((unsigned char*)d_ws + WS_CTL, 0, CTL_ZERO_BYTES, stream);
    Args a{}; for (int i = 0; i < N_IN; ++i) a.in[i] = (const float*)d_in[i]; a.out = (float*)d_out; a.ws = (unsigned char*)d_ws;
    a.ph_lo = 0; a.ph_hi = PH_END;
    hipLaunchKernelGGL(mk_fwd, dim3(grid), dim3(NTHREADS), LDS_BYTES, stream, a);
}
```
